# Optimizing an MI355X kernel written in HIP

```python
import math
import jax, jax.numpy as jnp
from jax import lax
import numpy as np

D_MODEL = 1024
BATCH = 4
SEQ = 4096
DEPTH = 2
DEC_BATCH = 128
DEC_SEQ = 1
PAST_LEN = 8192
PAGE_SIZE = 128

N_A_LAYERS = (DEPTH + 1) // 2
N_C_LAYERS = DEPTH // 2
EPS = 1e-6
CONV_W = 4
CHUNK = 64
Q_BLOCK = 128
GDN_HEADS = 4
GDN_DK = 128
GDN_DV = 128
GDN_QK = GDN_HEADS * GDN_DK
GDN_VW = GDN_HEADS * GDN_DV
GDN_CONV_CH = 2 * GDN_QK + GDN_VW
SSM_HEADS = 8
SSM_P = 64
SSM_N = 128
SSM_GROUPS = 2
SSM_INNER = SSM_HEADS * SSM_P
SSM_BC = SSM_GROUPS * SSM_N
SSM_CONV_CH = SSM_INNER + 2 * SSM_BC
IN_A_WIDTHS = (GDN_CONV_CH, GDN_VW, GDN_HEADS, GDN_HEADS, SSM_INNER, SSM_CONV_CH, SSM_HEADS)
IN_A = sum(IN_A_WIDTHS)
MIX_A = GDN_VW + SSM_INNER
MLA_HEADS = 16
Q_LORA = 512
KV_LORA = 256
QK_NOPE = 64
QK_ROPE = 32
QK_HEAD = QK_NOPE + QK_ROPE
V_HEAD = 64
MLA_IN = Q_LORA + KV_LORA + QK_ROPE
MLA_ROW = KV_LORA + QK_ROPE + MLA_HEADS
ROPE_THETA = 10000.0
D_FF = -(-8 * D_MODEL // (3 * 256)) * 256

kernel_name = 'hybrid_gdn_ssd_mla_decoder_step'


def rms_norm(x, g):
    xf = x.astype(jnp.float32)
    y = xf * lax.rsqrt(jnp.mean(xf * xf, axis=-1, keepdims=True) + EPS)
    return (y * g.astype(jnp.float32)).astype(x.dtype)


def l2_normalize(x):
    xf = x.astype(jnp.float32)
    return xf * lax.rsqrt(jnp.sum(xf * xf, axis=-1, keepdims=True) + EPS)


def rope(x, pos):
    half = x.shape[-1] // 2
    inv_freq = ROPE_THETA ** (-jnp.arange(half, dtype=jnp.float32) / half)
    ang = pos[:, None] * inv_freq[None, :]
    shape = (1, pos.shape[0]) + (1,) * (x.ndim - 3) + (half,)
    cos, sin = jnp.cos(ang).reshape(shape), jnp.sin(ang).reshape(shape)
    x1, x2 = x[..., :half], x[..., half:]
    return jnp.concatenate([x1 * cos - x2 * sin, x2 * cos + x1 * sin], axis=-1)


def causal_conv(x, prev, w):
    T = x.shape[1]
    xp = jnp.concatenate([prev.astype(x.dtype), x], axis=1)
    y = sum(w[i] * xp[:, i:i + T] for i in range(CONV_W))
    return y, xp[:, xp.shape[1] - (CONV_W - 1):]


def to_chunks(a, chunk):
    B, T = a.shape[:2]
    return jnp.moveaxis(a.reshape((B, T // chunk, chunk) + a.shape[2:]), 1, 0)


def from_chunks(a):
    n, B, C = a.shape[:3]
    return jnp.moveaxis(a, 0, 1).reshape((B, n * C) + a.shape[3:])


def gated_delta_chunked(q, k, v, g, beta, S0, chunk):
    f32 = jnp.float32
    incl = jnp.tril(jnp.ones((chunk, chunk), bool))
    strict = jnp.tril(jnp.ones((chunk, chunk), bool), -1)
    eye = jnp.eye(chunk, dtype=f32)
    dv = v.shape[-1]

    def step(S, inp):
        qi, ki, vi, gi, bi = (jnp.swapaxes(a.astype(f32), 1, 2) for a in inp)
        cum = jnp.cumsum(gi, axis=-1)
        decay = jnp.exp(jnp.where(incl, cum[..., :, None] - cum[..., None, :], -jnp.inf))
        kb = ki * bi[..., None]
        lower = jnp.where(strict, jnp.einsum('bhid,bhjd->bhij', kb, ki) * decay, 0.0)
        rhs = jnp.concatenate([vi * bi[..., None], kb * jnp.exp(cum)[..., None]], axis=-1)
        sol = lax.linalg.triangular_solve(eye + lower, rhs, left_side=True, lower=True,
                                          unit_diagonal=True)
        u, w = sol[..., :dv], sol[..., dv:]
        v_new = u - w @ S
        attn = jnp.einsum('bhid,bhjd->bhij', qi, ki) * decay
        o = (qi * jnp.exp(cum)[..., None]) @ S + attn @ v_new
        last = cum[..., -1:]
        S = S * jnp.exp(last)[..., None] + jnp.einsum(
            'bhjd,bhjv->bhdv', ki * jnp.exp(last - cum)[..., None], v_new)
        return S, jnp.swapaxes(o, 1, 2)

    S, o = lax.scan(step, S0.astype(f32), tuple(to_chunks(a, chunk) for a in (q, k, v, g, beta)))
    return from_chunks(o), S


def ssd_chunked(x, dt, A, Bh, Ch, h0, chunk):
    f32 = jnp.float32
    incl = jnp.tril(jnp.ones((chunk, chunk), bool))
    la = dt * A
    xdt = x.astype(f32) * dt[..., None]

    def step(h, inp):
        xi, lai, bi, ci = inp
        cum = jnp.cumsum(lai, axis=1)
        cum_h = jnp.swapaxes(cum, 1, 2)
        seg = jnp.exp(jnp.where(incl, cum_h[..., :, None] - cum_h[..., None, :], -jnp.inf))
        scores = jnp.einsum('bihn,bjhn->bhij', ci, bi) * seg
        y = (jnp.einsum('bhij,bjhp->bihp', scores, xi)
             + jnp.einsum('bihn,bhpn->bihp', ci, h) * jnp.exp(cum)[..., None])
        last = cum[:, -1:]
        h = h * jnp.exp(last[:, 0])[..., None, None] + jnp.einsum(
            'bjhn,bjhp->bhpn', bi * jnp.exp(last - cum)[..., None], xi)
        return h, y

    h, y = lax.scan(step, h0.astype(f32),
                    tuple(to_chunks(a, chunk) for a in (xdt, la, Bh.astype(f32), Ch.astype(f32))))
    return from_chunks(y), h


def hybrid_layer(x, S0, gconv0, h0, sconv0, chunk, norm_g, w_in, conv_gdn_w, gdn_A_log,
                 gdn_dt_bias, gdn_norm, conv_ssm_w, conv_ssm_b, ssm_A_log, ssm_dt_bias, ssm_D,
                 ssm_norm, w_out):
    B, T, _ = x.shape
    f32 = jnp.float32
    proj = rms_norm(x, norm_g) @ w_in
    g_qkv, g_z, g_a, g_b, s_z, s_xbc, s_dt = jnp.split(
        proj, np.cumsum(IN_A_WIDTHS)[:-1].tolist(), axis=-1)
    qkv, gdn_conv = causal_conv(g_qkv, gconv0, conv_gdn_w)
    q, k, v = jnp.split(jax.nn.silu(qkv), [GDN_QK, 2 * GDN_QK], axis=-1)
    q = l2_normalize(q.reshape(B, T, GDN_HEADS, GDN_DK)) * GDN_DK ** -0.5
    k = l2_normalize(k.reshape(B, T, GDN_HEADS, GDN_DK))
    v = v.reshape(B, T, GDN_HEADS, GDN_DV)
    beta = jax.nn.sigmoid(g_b.astype(f32))
    g = -jnp.exp(gdn_A_log.astype(f32)) * jax.nn.softplus(g_a.astype(f32) + gdn_dt_bias)
    o, S = gated_delta_chunked(q, k, v, g, beta, S0, chunk)
    o = rms_norm(o, gdn_norm) * jax.nn.silu(g_z.reshape(B, T, GDN_HEADS, GDN_DV).astype(f32))
    xbc, ssm_conv = causal_conv(s_xbc, sconv0, conv_ssm_w)
    xs, bm, cm = jnp.split(jax.nn.silu(xbc + conv_ssm_b), [SSM_INNER, SSM_INNER + SSM_BC], axis=-1)
    xs = xs.reshape(B, T, SSM_HEADS, SSM_P)
    rep = SSM_HEADS // SSM_GROUPS
    bh = jnp.repeat(bm.reshape(B, T, SSM_GROUPS, SSM_N), rep, axis=2)
    ch = jnp.repeat(cm.reshape(B, T, SSM_GROUPS, SSM_N), rep, axis=2)
    dt = jax.nn.softplus(s_dt.astype(f32) + ssm_dt_bias)
    y, h = ssd_chunked(xs, dt, -jnp.exp(ssm_A_log.astype(f32)), bh, ch, h0, chunk)
    y = (y + ssm_D[:, None] * xs).reshape(B, T, SSM_INNER) * jax.nn.silu(s_z.astype(f32))
    y = rms_norm(y.reshape(B, T, SSM_GROUPS, SSM_INNER // SSM_GROUPS),
                 ssm_norm.reshape(SSM_GROUPS, -1)).reshape(B, T, SSM_INNER)
    mix = jnp.concatenate([o.reshape(B, T, GDN_VW), y], axis=-1).astype(x.dtype) @ w_out
    return x + mix, (S, gdn_conv, h, ssm_conv)


def causal_block_attention(q, k, v):
    B, T, H, Dq = q.shape
    nb = T // Q_BLOCK
    q_blocks = jnp.moveaxis(q.reshape(B, nb, Q_BLOCK, H, Dq), 1, 0)
    k_pos = jnp.arange(T)
    scale = Dq ** -0.5

    def attend(args):
        qb, start = args
        s = jnp.einsum('bqhd,bkhd->bhqk', qb, k).astype(jnp.float32) * scale
        q_pos = start + jnp.arange(Q_BLOCK)
        s = jnp.where(k_pos[None, :] <= q_pos[:, None], s, -jnp.inf)
        return jnp.einsum('bhqk,bkhd->bqhd', jax.nn.softmax(s, axis=-1), v)

    o = lax.map(attend, (q_blocks, jnp.arange(nb) * Q_BLOCK))
    return jnp.moveaxis(o, 0, 1).reshape(B, T, H, v.shape[-1])


def latent_scores(qa, q_rope, rows):
    c, kr, inv_r = jnp.split(rows, [KV_LORA, KV_LORA + QK_ROPE], axis=-1)
    s = (jnp.einsum('bthc,bsc->bhts', qa, c).astype(jnp.float32)
         + jnp.einsum('bthr,bsr->bhts', q_rope, kr).astype(jnp.float32))
    return s * jnp.swapaxes(inv_r, 1, 2)[:, :, None, :].astype(jnp.float32) * QK_HEAD ** -0.5


def mla_layer(x, pos, past, norm_g, w_in, q_a_norm, kv_a_norm, w_uq, w_uk, w_uv, q_norm, k_norm,
              w_out):
    B, T, _ = x.shape
    f32 = jnp.float32
    cq, ckv, kr = jnp.split(rms_norm(x, norm_g) @ w_in, [Q_LORA, Q_LORA + KV_LORA], axis=-1)
    q = rms_norm((rms_norm(cq, q_a_norm) @ w_uq).reshape(B, T, MLA_HEADS, QK_HEAD), q_norm)
    q_nope, q_rope = q[..., :QK_NOPE], rope(q[..., QK_NOPE:], pos)
    c = rms_norm(ckv, kv_a_norm)
    k_nope = jnp.einsum('btc,chd->bthd', c, w_uk)
    krf = kr.astype(f32)
    ssq = jnp.sum(jnp.square(k_nope.astype(f32)), axis=-1) + jnp.sum(krf * krf, axis=-1)[..., None]
    inv_r = lax.rsqrt(ssq / QK_HEAD + EPS)
    kr_rot = rope(kr * k_norm[QK_NOPE:], pos)
    rows = jnp.concatenate([c, kr_rot, inv_r.astype(c.dtype)], axis=-1)
    if past is None:
        k = jnp.concatenate([k_nope * k_norm[:QK_NOPE],
                             jnp.broadcast_to(kr_rot[:, :, None, :], (B, T, MLA_HEADS, QK_ROPE))],
                            axis=-1) * inv_r[..., None]
        v = jnp.einsum('btc,chv->bthv', c, w_uv)
        o = causal_block_attention(jnp.concatenate([q_nope, q_rope], axis=-1), k, v)
    else:
        qa = jnp.einsum('bthd,chd->bthc', q_nope * k_norm[:QK_NOPE], w_uk)
        s_past = latent_scores(qa, q_rope, past)
        s_new = jnp.where(jnp.tril(jnp.ones((T, T), bool)), latent_scores(qa, q_rope, rows), -jnp.inf)
        p = jax.nn.softmax(jnp.concatenate([s_past, s_new], axis=-1), axis=-1)
        n_past = past.shape[1]
        ctx = (jnp.einsum('bhts,bsc->bthc', p[..., :n_past], past[..., :KV_LORA].astype(f32))
               + jnp.einsum('bhts,bsc->bthc', p[..., n_past:], c.astype(f32)))
        o = jnp.einsum('bthc,chv->bthv', ctx, w_uv)
    y = o.reshape(B, T, MLA_HEADS * V_HEAD).astype(x.dtype) @ w_out
    return x + y, rows


def swiglu_ffn(x, norm_g, w_gate_up, w_down):
    gate, up = jnp.split(rms_norm(x, norm_g) @ w_gate_up, 2, axis=-1)
    return x + (jax.nn.silu(gate) * up) @ w_down


def trunk(x, pos, gdn_S, gdn_conv, ssm_h, ssm_conv, cache_mla, page_table, wa, wc, wf):
    T = x.shape[1]
    chunk = CHUNK if T % CHUNK == 0 else T
    new_S, new_gc, new_h, new_sc, new_rows = [], [], [], [], []
    norm_ffn, w_gate_up, w_down = wf
    for layer in range(DEPTH):
        j = layer // 2
        if layer % 2 == 0:
            x, (S, gc, h, sc) = hybrid_layer(x, gdn_S[j], gdn_conv[j], ssm_h[j], ssm_conv[j], chunk,
                                             *[w[j] for w in wa])
            new_S.append(S)
            new_gc.append(gc)
            new_h.append(h)
            new_sc.append(sc)
        else:
            past = None if cache_mla is None else cache_mla[j, page_table].reshape(
                x.shape[0], -1, MLA_ROW)
            x, rows = mla_layer(x, pos, past, *[w[j] for w in wc])
            new_rows.append(rows)
        x = swiglu_ffn(x, norm_ffn[layer], w_gate_up[layer], w_down[layer])
    return (x, jnp.stack(new_S), jnp.stack(new_gc), jnp.stack(new_h), jnp.stack(new_sc),
            jnp.stack(new_rows))


def setup_inputs(seed: int = 0) -> dict:
    keys = iter(jax.random.split(jax.random.key(seed), 64))
    f32 = jnp.float32

    def normal(shape, scale=1.0):
        return jax.random.normal(next(keys), shape, f32) * scale

    def uniform(shape, lo, hi):
        return jax.random.uniform(next(keys), shape, f32, lo, hi)

    def gain(shape):
        return 1.0 + normal(shape, 0.02)

    def dt_bias(shape):
        dt = jnp.exp(uniform(shape, math.log(1e-3), math.log(1e-1)))
        return dt + jnp.log(-jnp.expm1(-dt))

    na, nc = N_A_LAYERS, N_C_LAYERS
    n_pages = PAST_LEN // PAGE_SIZE
    n_pool = (5 * DEC_BATCH * n_pages) // 4
    x_prompt = normal((BATCH, SEQ, D_MODEL))
    x_sample = normal((DEC_BATCH, DEC_SEQ, D_MODEL))
    state_gdn = normal((na, DEC_BATCH, GDN_HEADS, GDN_DK, GDN_DV), 0.1)
    state_gdn_conv = normal((na, DEC_BATCH, CONV_W - 1, GDN_CONV_CH))
    state_ssm = normal((na, DEC_BATCH, SSM_HEADS, SSM_P, SSM_N), 0.1)
    state_ssm_conv = normal((na, DEC_BATCH, CONV_W - 1, SSM_CONV_CH))
    cache_mla = jnp.concatenate([normal((nc, n_pool, PAGE_SIZE, KV_LORA)),
                                 normal((nc, n_pool, PAGE_SIZE, QK_ROPE)),
                                 uniform((nc, n_pool, PAGE_SIZE, MLA_HEADS), 0.7, 1.3)], axis=-1)
    page_table = jax.random.permutation(next(keys), n_pool)[:DEC_BATCH * n_pages].reshape(
        DEC_BATCH, n_pages).astype(jnp.int32)
    return {
        'x_prompt': x_prompt,
        'x_sample': x_sample,
        'state_gdn': state_gdn,
        'state_gdn_conv': state_gdn_conv,
        'state_ssm': state_ssm,
        'state_ssm_conv': state_ssm_conv,
        'cache_mla': cache_mla,
        'page_table': page_table,
        'norm_mix_a': gain((na, D_MODEL)),
        'w_in_a': normal((na, D_MODEL, IN_A), D_MODEL ** -0.5),
        'conv_gdn_w': normal((na, CONV_W, GDN_CONV_CH), CONV_W ** -0.5),
        'gdn_A_log': jnp.log(uniform((na, GDN_HEADS), 1.0, 16.0)),
        'gdn_dt_bias': dt_bias((na, GDN_HEADS)),
        'gdn_norm': gain((na, GDN_DV)),
        'conv_ssm_w': normal((na, CONV_W, SSM_CONV_CH), CONV_W ** -0.5),
        'conv_ssm_b': normal((na, SSM_CONV_CH), 0.1),
        'ssm_A_log': jnp.log(uniform((na, SSM_HEADS), 1.0, 16.0)),
        'ssm_dt_bias': dt_bias((na, SSM_HEADS)),
        'ssm_D': gain((na, SSM_HEADS)),
        'ssm_norm': gain((na, SSM_INNER)),
        'w_out_a': normal((na, MIX_A, D_MODEL), MIX_A ** -0.5),
        'norm_mix_c': gain((nc, D_MODEL)),
        'w_in_c': normal((nc, D_MODEL, MLA_IN), D_MODEL ** -0.5),
        'q_a_norm': gain((nc, Q_LORA)),
        'kv_a_norm': gain((nc, KV_LORA)),
        'w_uq': normal((nc, Q_LORA, MLA_HEADS * QK_HEAD), Q_LORA ** -0.5),
        'w_uk': normal((nc, KV_LORA, MLA_HEADS, QK_NOPE), KV_LORA ** -0.5),
        'w_uv': normal((nc, KV_LORA, MLA_HEADS, V_HEAD), KV_LORA ** -0.5),
        'q_norm': gain((nc, QK_HEAD)),
        'k_norm': gain((nc, QK_HEAD)),
        'w_out_c': normal((nc, MLA_HEADS * V_HEAD, D_MODEL), (MLA_HEADS * V_HEAD) ** -0.5),
        'norm_ffn': gain((DEPTH, D_MODEL)),
        'w_gate_up': normal((DEPTH, D_MODEL, 2 * D_FF), D_MODEL ** -0.5),
        'w_down': normal((DEPTH, D_FF, D_MODEL), D_FF ** -0.5),
    }


def reference(x_prompt, x_sample, state_gdn, state_gdn_conv, state_ssm, state_ssm_conv, cache_mla,
              page_table, norm_mix_a, w_in_a, conv_gdn_w, gdn_A_log, gdn_dt_bias, gdn_norm,
              conv_ssm_w, conv_ssm_b, ssm_A_log, ssm_dt_bias, ssm_D, ssm_norm, w_out_a,
              norm_mix_c, w_in_c, q_a_norm, kv_a_norm, w_uq, w_uk, w_uv, q_norm, k_norm, w_out_c,
              norm_ffn, w_gate_up, w_down):
    wa = (norm_mix_a, w_in_a, conv_gdn_w, gdn_A_log, gdn_dt_bias, gdn_norm, conv_ssm_w,
          conv_ssm_b, ssm_A_log, ssm_dt_bias, ssm_D, ssm_norm, w_out_a)
    wc = (norm_mix_c, w_in_c, q_a_norm, kv_a_norm, w_uq, w_uk, w_uv, q_norm, k_norm, w_out_c)
    wf = (norm_ffn, w_gate_up, w_down)
    b, t, _ = x_prompt.shape
    zero_S = jnp.zeros((N_A_LAYERS, b, GDN_HEADS, GDN_DK, GDN_DV), jnp.float32)
    zero_gc = jnp.zeros((N_A_LAYERS, b, CONV_W - 1, GDN_CONV_CH), x_prompt.dtype)
    zero_h = jnp.zeros((N_A_LAYERS, b, SSM_HEADS, SSM_P, SSM_N), jnp.float32)
    zero_sc = jnp.zeros((N_A_LAYERS, b, CONV_W - 1, SSM_CONV_CH), x_prompt.dtype)
    y_prompt, p_gdn, p_gdn_conv, p_ssm, p_ssm_conv, p_mla_rows = trunk(
        x_prompt, jnp.arange(t, dtype=jnp.float32), zero_S, zero_gc, zero_h, zero_sc, None, None,
        wa, wc, wf)
    past_len = page_table.shape[1] * PAGE_SIZE
    pos_s = past_len + jnp.arange(x_sample.shape[1], dtype=jnp.float32)
    y_sample, s_gdn, s_gdn_conv, s_ssm, s_ssm_conv, s_mla_rows = trunk(
        x_sample, pos_s, state_gdn, state_gdn_conv, state_ssm, state_ssm_conv, cache_mla,
        page_table, wa, wc, wf)
    return (y_prompt, y_sample, p_gdn, p_gdn_conv, p_ssm, p_ssm_conv, p_mla_rows,
            s_gdn, s_gdn_conv, s_ssm, s_ssm_conv, s_mla_rows)
```

```cpp
#include <hip/hip_runtime.h>
#include <cstdio>
#include <cstdint>
#include <cmath>
namespace pg8 {
#define PG8_LAS __attribute__((address_space(3)))
typedef unsigned short bf16_t;
typedef short bf16x8 __attribute__((ext_vector_type(8)));
typedef float f32x4 __attribute__((ext_vector_type(4)));
typedef unsigned u32x4 __attribute__((ext_vector_type(4)));
constexpr int BM = 256, BK = 64, HALF = 128, HTB = HALF * BK * 2  , STAGE_BYTES = 8 * HTB, NXCD = 8, WGM = 8;

__host__ __device__ __forceinline__ int lds_byte(int r, int c) { const int st = (r >> 4) * 2 + (c >> 5), rr = r & 15, cc = c & 31, ob = rr * 64 + cc * 2; return st * 1024 + (ob ^ (((ob >> 9) & 1) << 5)); }
__host__ __device__ __forceinline__ void stage_rc(int b, int& R, int& C) { const int st = b / 1024, sb = b % 1024, swz = sb ^ (((sb >> 9) & 1) << 5); R = (st >> 1) * 16 + swz / 64; C = (st & 1) * 32 + (swz % 64) / 2; }
__host__ __device__ __forceinline__ int perm32(int rho) { const int n = rho >> 4, i = rho & 15; return 8 * (i >> 2) + 4 * n + (i & 3); }

struct Unit { int pm, pn; };
struct Gemm { const bf16_t* A; const bf16_t* Bt; int M, N, K; };

struct StaticOrder {
    int nM, nN, nwg, G, c;
    __host__ __device__ void init(int M, int N, int G_, int c_) { nM = M / BM; nN = N / BM; nwg = nM * nN; G = G_; c = c_; }
    __host__ __device__ bool next(int i, Unit& u) const {
        const long L = (long)i * G + c; if (L >= nwg) return false;
        int wgid = (int)L; { const int q = nwg / NXCD, r = nwg % NXCD, xcd = wgid % NXCD, off = wgid / NXCD; wgid = (xcd < r ? xcd * (q + 1) : r * (q + 1) + (xcd - r) * q) + off; }
        const int nig = WGM * nN, gid = wgid / nig, fm = gid * WGM, gsz = (nM - fm) < WGM ? (nM - fm) : WGM;
        u.pm = fm + ((wgid % nig) % gsz); u.pn = (wgid % nig) / gsz; return true;
    }
    __device__ __forceinline__ void a_ready(const Unit&) const {}
    __device__ __forceinline__ void done(const Unit&) const {}
};

__device__ __forceinline__ unsigned cvt_pk_bf16(float lo, float hi) { unsigned r; asm volatile("v_cvt_pk_bf16_f32 %0, %1, %2" : "=v"(r) : "v"(lo), "v"(hi)); return r; }
typedef float f32x2 __attribute__((ext_vector_type(2)));
__device__ __forceinline__ f32x2 gelu_pk(f32x2 v) {
    const f32x2 av = __builtin_elementwise_abs(v), d = av * 0.2316418882f + 1.0f;
    f32x2 t; t.x = __builtin_amdgcn_rcpf(d.x); t.y = __builtin_amdgcn_rcpf(d.y);
    f32x2 q = t * 0.5307027145f + (-0.7265760135f); q = q * t + 0.7107068705f; q = q * t + (-0.142248368f); q = q * t + 0.127414796f; q = q * t;
    const f32x2 s = (v * v) * (-0.72134752044f);
    f32x2 e; e.x = __builtin_amdgcn_exp2f(s.x); e.y = __builtin_amdgcn_exp2f(s.y);
    const f32x2 m = v * (q * e), r = v - m;
    f32x2 o; o.x = v.x < 0.f ? m.x : r.x; o.y = v.y < 0.f ? m.y : r.y; return o;
}

template <int ACT  > struct EpiBf16 {
    static constexpr bool PERM = true, AFTER_DRAIN = false; static_assert(ACT == 0 || ACT == 1, "EpiBf16: ACT is 0 (none) or 1 (gelu_pk)");
    bf16_t* O; int ldc; const float* bias; int split_cols; size_t split_stride; float scale0;
    __device__ __forceinline__ void operator()(const f32x4 (&acc)[2][2][4][2], const Unit& u, int wr, int wc, int fr, int fq) const {
        const int row0 = u.pm * BM + wr * 64 + fr; int colt = u.pn * BM; bf16_t* base = O;
        float sc = 1.f; if (split_cols) { const int t = colt / split_cols; base += (size_t)t * split_stride; colt -= t * split_cols; if (t == 0) sc = scale0; }
        const int col0 = colt + wc * 32 + 8 * fq, bcol0 = u.pn * BM + wc * 32 + 8 * fq;
        f32x4 bv[2][2];
#pragma unroll
        for (int bj = 0; bj < 2; ++bj)
#pragma unroll
            for (int n = 0; n < 2; ++n) bv[bj][n] = bias ? *(const f32x4*)(bias + bcol0 + bj * HALF + 4 * n) : (f32x4){0.f, 0.f, 0.f, 0.f};
#pragma unroll
        for (int ai = 0; ai < 2; ++ai)
#pragma unroll
            for (int m = 0; m < 4; ++m) { bf16_t* rowp = base + (size_t)(row0 + ai * HALF + m * 16) * ldc + col0;
#pragma unroll
                for (int bj = 0; bj < 2; ++bj) { f32x4 v0 = acc[ai][bj][m][0] + bv[bj][0], v1 = acc[ai][bj][m][1] + bv[bj][1];
                    if (ACT == 1) { f32x2 a = gelu_pk((f32x2){v0[0], v0[1]}), b = gelu_pk((f32x2){v0[2], v0[3]}), c = gelu_pk((f32x2){v1[0], v1[1]}), d = gelu_pk((f32x2){v1[2], v1[3]});
                        v0 = (f32x4){a.x, a.y, b.x, b.y}; v1 = (f32x4){c.x, c.y, d.x, d.y}; }
                    v0 = v0 * sc; v1 = v1 * sc; u32x4 w; w.x = cvt_pk_bf16(v0[0], v0[1]); w.y = cvt_pk_bf16(v0[2], v0[3]); w.z = cvt_pk_bf16(v1[0], v1[1]); w.w = cvt_pk_bf16(v1[2], v1[3]);
                    *(u32x4*)(rowp + bj * HALF) = w; } }
    }
};
__device__ __forceinline__ float fast_silu(float g) { return g * __builtin_amdgcn_rcpf(1.0f + __builtin_amdgcn_exp2f(-1.4426950408889634f * g)); }
struct EpiF32 {
    static constexpr bool PERM = false, AFTER_DRAIN = false;
    float* C; int ldc; const float* ssq;
    __device__ __forceinline__ void operator()(const f32x4 (&acc)[2][2][4][2], const Unit& u, int wr, int wc, int fr, int fq) const {
        const int row0 = u.pm * BM + wr * 64 + fr, col0 = u.pn * BM + wc * 32 + 4 * fq;
#pragma unroll
        for (int ai = 0; ai < 2; ++ai)
#pragma unroll
            for (int m = 0; m < 4; ++m) { const int row = row0 + ai * HALF + m * 16; float* rowp = C + (size_t)row * ldc + col0; const float rs = __builtin_amdgcn_rsqf(ssq[row] * (1.f / 1024.f) + 1e-6f);
#pragma unroll
                for (int bj = 0; bj < 2; ++bj)
#pragma unroll
                    for (int n = 0; n < 2; ++n) *(f32x4*)(rowp + bj * HALF + n * 16) = acc[ai][bj][m][n] * rs; }
    }
};
struct EpiResF32 {
    static constexpr bool PERM = false, AFTER_DRAIN = false;
    const float* Rf; const bf16_t* Rb; int ldc; bf16_t* XN; float* ssq; float* Yf;
    __device__ __forceinline__ void operator()(const f32x4 (&acc)[2][2][4][2], const Unit& u, int wr, int wc, int fr, int fq) const {
        typedef unsigned u32x2v __attribute__((ext_vector_type(2)));
        const int row0 = u.pm * BM + wr * 64 + fr, col0 = u.pn * BM + wc * 32 + 4 * fq;
#pragma unroll
        for (int ai = 0; ai < 2; ++ai)
#pragma unroll
            for (int m = 0; m < 4; ++m) { const int row = row0 + ai * HALF + m * 16; const size_t off = (size_t)row * ldc + col0; float sq = 0.f;
#pragma unroll
                for (int bj = 0; bj < 2; ++bj)
#pragma unroll
                    for (int n = 0; n < 2; ++n) { const size_t o2 = off + bj * HALF + n * 16; f32x4 r;
                        if (Rf) r = *(const f32x4*)(Rf + o2);
                        else { const u32x2v rb = *(const u32x2v*)(Rb + o2); r[0] = __uint_as_float(rb.x << 16); r[1] = __uint_as_float(rb.x & 0xffff0000u); r[2] = __uint_as_float(rb.y << 16); r[3] = __uint_as_float(rb.y & 0xffff0000u); }
                        const f32x4 v = acc[ai][bj][m][n] + r;
                        if (Yf) *(f32x4*)(Yf + o2) = v;
                        if (XN) { u32x2v w; w.x = cvt_pk_bf16(v[0], v[1]); w.y = cvt_pk_bf16(v[2], v[3]); *(u32x2v*)(XN + o2) = w;
                            sq += (v[0] * v[0] + v[1] * v[1]) + (v[2] * v[2] + v[3] * v[3]); } }
                if (XN) { sq += __shfl_xor(sq, 16); sq += __shfl_xor(sq, 32); if (fq == 0) atomicAdd(ssq + row, sq); } }
    }
};
struct EpiSwiGLU {
    static constexpr bool PERM = true, AFTER_DRAIN = false;
    bf16_t* H; int ldh; const float* ssq;
    __device__ __forceinline__ void operator()(const f32x4 (&acc)[2][2][4][2], const Unit& u, int wr, int wc, int fr, int fq) const {
        const int row0 = u.pm * BM + wr * 64 + fr, col0 = u.pn * HALF + wc * 32 + 8 * fq;
#pragma unroll
        for (int ai = 0; ai < 2; ++ai)
#pragma unroll
            for (int m = 0; m < 4; ++m) { const int row = row0 + ai * HALF + m * 16; bf16_t* rowp = H + (size_t)row * ldh + col0; const float rs = __builtin_amdgcn_rsqf(ssq[row] * (1.f / 1024.f) + 1e-6f);
                const f32x4 g0 = acc[ai][0][m][0] * rs, g1 = acc[ai][0][m][1] * rs, u0 = acc[ai][1][m][0] * rs, u1 = acc[ai][1][m][1] * rs;
                u32x4 w; w.x = cvt_pk_bf16(fast_silu(g0[0]) * u0[0], fast_silu(g0[1]) * u0[1]); w.y = cvt_pk_bf16(fast_silu(g0[2]) * u0[2], fast_silu(g0[3]) * u0[3]);
                w.z = cvt_pk_bf16(fast_silu(g1[0]) * u1[0], fast_silu(g1[1]) * u1[1]); w.w = cvt_pk_bf16(fast_silu(g1[2]) * u1[2], fast_silu(g1[3]) * u1[3]);
                *(u32x4*)rowp = w; }
    }
};

struct EpiBf16Rs {
    static constexpr bool PERM = true, AFTER_DRAIN = false;
    bf16_t* O; int ldc; const float* ssq; float inv_n; int split_cols; size_t split_stride;
    __device__ __forceinline__ void operator()(const f32x4 (&acc)[2][2][4][2], const Unit& u, int wr, int wc, int fr, int fq) const {
        const int row0 = u.pm * BM + wr * 64 + fr; int colt = u.pn * BM; bf16_t* base = O;
        if (split_cols) { const int t = colt / split_cols; base += (size_t)t * split_stride; colt -= t * split_cols; }
        const int col0 = colt + wc * 32 + 8 * fq;
#pragma unroll
        for (int ai = 0; ai < 2; ++ai)
#pragma unroll
            for (int m = 0; m < 4; ++m) { const int row = row0 + ai * HALF + m * 16; bf16_t* rowp = base + (size_t)row * ldc + col0; const float rs = __builtin_amdgcn_rsqf(ssq[row] * inv_n + 1e-6f);
#pragma unroll
                for (int bj = 0; bj < 2; ++bj) { const f32x4 v0 = acc[ai][bj][m][0] * rs, v1 = acc[ai][bj][m][1] * rs;
                    u32x4 w; w.x = cvt_pk_bf16(v0[0], v0[1]); w.y = cvt_pk_bf16(v0[2], v0[3]); w.z = cvt_pk_bf16(v1[0], v1[1]); w.w = cvt_pk_bf16(v1[2], v1[3]);
                    *(u32x4*)(rowp + bj * HALF) = w; } }
    }
};
struct EpiInC {
    static constexpr bool PERM = false, AFTER_DRAIN = false;
    float* C; int ldc; const float* ssq_x; bf16_t* CQ; bf16_t* CK; float* ssq_q; float* ssq_c;
    __device__ __forceinline__ void operator()(const f32x4 (&acc)[2][2][4][2], const Unit& u, int wr, int wc, int fr, int fq) const {
        typedef unsigned u32x2v __attribute__((ext_vector_type(2)));
        const int row0 = u.pm * BM + wr * 64 + fr, colt = wc * 32 + 4 * fq;
#pragma unroll
        for (int ai = 0; ai < 2; ++ai)
#pragma unroll
            for (int m = 0; m < 4; ++m) { const int row = row0 + ai * HALF + m * 16; const float rs = __builtin_amdgcn_rsqf(ssq_x[row] * (1.f / 1024.f) + 1e-6f); float sq = 0.f;
#pragma unroll
                for (int bj = 0; bj < 2; ++bj)
#pragma unroll
                    for (int n = 0; n < 2; ++n) { const f32x4 v = acc[ai][bj][m][n] * rs; const int cc = colt + bj * HALF + n * 16;
                        if (u.pn == 2 || (u.pn == 3 && cc < 32)) *(f32x4*)(C + (size_t)row * ldc + u.pn * BM + cc) = v;
                        if (u.pn < 3) { u32x2v w; w.x = cvt_pk_bf16(v[0], v[1]); w.y = cvt_pk_bf16(v[2], v[3]);
                            if (u.pn < 2) *(u32x2v*)(CQ + (size_t)row * 512 + u.pn * BM + cc) = w; else *(u32x2v*)(CK + (size_t)row * 256 + cc) = w;
                            sq += (v[0] * v[0] + v[1] * v[1]) + (v[2] * v[2] + v[3] * v[3]); } }
                if (u.pn < 3) { sq += __shfl_xor(sq, 16); sq += __shfl_xor(sq, 32); if (fq == 0) atomicAdd((u.pn < 2 ? ssq_q : ssq_c) + row, sq); } }
    }
};
template <class Epi, class Sched, bool ALIGN_EPI = false, bool SP2 = false>
__device__ __forceinline__ void gemm_phase(PG8_LAS unsigned char* lds, const Gemm g, const Sched& S, const Epi& E) {
    const int tid = threadIdx.x, wid = __builtin_amdgcn_readfirstlane(tid >> 6), lane = tid & 63, wr = wid >> 2, wc = wid & 3, fr = lane & 15, fq = lane >> 4;
    const int K = g.K, nt = K / BK;
    unsigned voffA[2], voffB[2];
#pragma unroll
    for (int i = 0; i < 2; ++i) { int R, C; stage_rc(tid * 16 + i * 8192, R, C); const int Rb = Epi::PERM ? ((R & ~31) + perm32(R & 31)) : R;
        voffA[i] = (unsigned)(R * K + C) * 2u; voffB[i] = (unsigned)(Rb * K + C) * 2u; }
    const size_t kstep = (size_t)(BK * 2);
    const size_t hstep = (size_t)HALF * K * 2;
    const size_t tstep = 2 * hstep;
    const unsigned ldsw = (unsigned)wid * 1024u;
    const int aoff = lds_byte(wr * 64 + fr, fq * 8), boff = lds_byte(wc * 32 + fr, fq * 8);
#define PG8_SA(b, h) (((b) * 2 + (h)) * HTB)
#define PG8_SB(b, h) ((4 + (b) * 2 + (h)) * HTB)
#define PG8_STAGE(bufoff, gbase, voff) do { _Pragma("unroll") for (int _i = 0; _i < 2; ++_i) \
        __builtin_amdgcn_global_load_lds((const unsigned*)((const char*)(gbase) + (voff)[_i]), (PG8_LAS unsigned*)(lds + (bufoff) + ldsw + _i * 8192), 16, 0, 0); } while (0)
#define PG8_LDA(dst, b, h) do { _Pragma("unroll") for (int m = 0; m < 4; ++m) _Pragma("unroll") for (int k = 0; k < 2; ++k) dst[m][k] = *(const PG8_LAS bf16x8*)(lds + PG8_SA(b, h) + aoff + m * 2048 + k * 1024); } while (0)
#define PG8_LDB(dst, b, h) do { _Pragma("unroll") for (int n = 0; n < 2; ++n) _Pragma("unroll") for (int k = 0; k < 2; ++k) dst[n][k] = *(const PG8_LAS bf16x8*)(lds + PG8_SB(b, h) + boff + n * 2048 + k * 1024); } while (0)
#define PG8_MMA(ai, bj, At, Bt) do { __builtin_amdgcn_s_setprio(1); _Pragma("unroll") for (int m = 0; m < 4; ++m) _Pragma("unroll") for (int n = 0; n < 2; ++n) _Pragma("unroll") for (int k = 0; k < 2; ++k) \
        acc[ai][bj][m][n] = __builtin_amdgcn_mfma_f32_16x16x32_bf16(Bt[n][k], At[m][k], acc[ai][bj][m][n], 0, 0, 0); __builtin_amdgcn_s_setprio(0); } while (0)
#define PG8_WAIT_V(n) asm volatile("s_waitcnt vmcnt(" #n ")" ::: "memory")
#define PG8_WAIT_L(n) asm volatile("s_waitcnt lgkmcnt(" #n ")" ::: "memory")
#define PG8_BAR __builtin_amdgcn_s_barrier()
#define PG8_SCHED __builtin_amdgcn_sched_barrier(0)
    Unit cur, nxt; int ui = 0;
    if (!S.next(0, cur)) return;
    f32x4 acc[2][2][4][2];
#pragma unroll
    for (int a = 0; a < 2; ++a)
#pragma unroll
        for (int b = 0; b < 2; ++b)
#pragma unroll
            for (int m = 0; m < 4; ++m)
#pragma unroll
                for (int n = 0; n < 2; ++n) acc[a][b][m][n] = (f32x4){0.f, 0.f, 0.f, 0.f};
    bf16x8 At[4][2], B0[2][2], B1[2][2];
    const char* cA = (const char*)g.A + (size_t)cur.pm * tstep; const char* cB = (const char*)g.Bt + (size_t)cur.pn * tstep;
    S.a_ready(cur);
    if constexpr (SP2) {
        PG8_STAGE(PG8_SB(0, 0), cB, voffB); PG8_STAGE(PG8_SB(0, 1), cB + hstep, voffB); PG8_STAGE(PG8_SA(0, 0), cA, voffA); PG8_STAGE(PG8_SA(0, 1), cA + hstep, voffA);
        if (wr == 1) PG8_BAR;
        PG8_WAIT_V(2); PG8_BAR;
        PG8_STAGE(PG8_SB(1, 0), cB + kstep, voffB); PG8_STAGE(PG8_SA(1, 0), cA + kstep, voffA); PG8_STAGE(PG8_SB(1, 1), cB + hstep + kstep, voffB);
        PG8_WAIT_V(6); PG8_BAR;
    } else {
        PG8_STAGE(PG8_SB(0, 0), cB, voffB); PG8_STAGE(PG8_SA(0, 0), cA, voffA); PG8_STAGE(PG8_SB(0, 1), cB + hstep, voffB); PG8_STAGE(PG8_SA(0, 1), cA + hstep, voffA);
        if (wr == 1) PG8_BAR;
        PG8_WAIT_V(4); PG8_BAR;
        PG8_STAGE(PG8_SB(1, 0), cB + kstep, voffB); PG8_STAGE(PG8_SA(1, 0), cA + kstep, voffA); PG8_STAGE(PG8_SB(1, 1), cB + hstep + kstep, voffB);
        PG8_WAIT_V(6); PG8_BAR;
    }
    for (;;) {
        const bool has_next = S.next(ui + 1, nxt);
        const char* nA = has_next ? (const char*)g.A + (size_t)nxt.pm * tstep : cA; const char* nB = has_next ? (const char*)g.Bt + (size_t)nxt.pn * tstep : cB;
        for (int t = 0; t < nt; t += 2) {
            const bool last = (t == nt - 2);
            const char* a1 = cA + (size_t)(t + 1) * kstep;
            const char* a2 = last ? nA : cA + (size_t)(t + 2) * kstep; const char* b2 = last ? nB : cB + (size_t)(t + 2) * kstep;
            const char* a3 = a2 + kstep; const char* b3 = b2 + kstep;
            if (last && has_next) S.a_ready(nxt);
            if constexpr (SP2) {
            PG8_LDB(B0, 0, 0); PG8_LDB(B1, 0, 1); PG8_SCHED; PG8_LDA(At, 0, 0); PG8_STAGE(PG8_SA(1, 1), a1 + hstep, voffA);
            PG8_WAIT_V(8); PG8_WAIT_L(0); PG8_BAR; PG8_MMA(0, 0, At, B0); PG8_MMA(0, 1, At, B1); PG8_BAR; PG8_SCHED;
            PG8_LDA(At, 0, 1); PG8_STAGE(PG8_SB(0, 0), b2, voffB); PG8_STAGE(PG8_SB(0, 1), b2 + hstep, voffB); PG8_STAGE(PG8_SA(0, 0), a2, voffA);
            PG8_WAIT_V(8); PG8_WAIT_L(0); PG8_BAR; PG8_MMA(1, 0, At, B0); PG8_MMA(1, 1, At, B1); PG8_BAR; PG8_SCHED;
            PG8_LDB(B0, 1, 0); PG8_LDB(B1, 1, 1); PG8_SCHED; PG8_LDA(At, 1, 0); PG8_STAGE(PG8_SA(0, 1), a2 + hstep, voffA);
            PG8_WAIT_V(8); PG8_WAIT_L(0); PG8_BAR; PG8_MMA(0, 0, At, B0); PG8_MMA(0, 1, At, B1); PG8_BAR; PG8_SCHED;
            PG8_LDA(At, 1, 1); PG8_STAGE(PG8_SB(1, 0), b3, voffB); PG8_STAGE(PG8_SB(1, 1), b3 + hstep, voffB); PG8_STAGE(PG8_SA(1, 0), a3, voffA);
            PG8_WAIT_V(8); PG8_WAIT_L(0); PG8_BAR; PG8_MMA(1, 0, At, B0); PG8_MMA(1, 1, At, B1); PG8_BAR; PG8_SCHED;
            } else {
            PG8_LDB(B0, 0, 0); PG8_SCHED; PG8_LDA(At, 0, 0); PG8_STAGE(PG8_SA(1, 1), a1 + hstep, voffA);
            PG8_WAIT_L(8); PG8_BAR; PG8_WAIT_L(0); PG8_MMA(0, 0, At, B0); PG8_BAR; PG8_SCHED;
            PG8_LDB(B1, 0, 1); PG8_STAGE(PG8_SB(0, 0), b2, voffB);
            PG8_BAR; PG8_WAIT_L(0); PG8_MMA(0, 1, At, B1); PG8_BAR;
            PG8_LDA(At, 0, 1); PG8_STAGE(PG8_SA(0, 0), a2, voffA);
            PG8_BAR; PG8_WAIT_L(0); PG8_MMA(1, 0, At, B0); PG8_BAR; PG8_SCHED;
            PG8_STAGE(PG8_SB(0, 1), b2 + hstep, voffB);
            PG8_WAIT_V(6); PG8_BAR; PG8_MMA(1, 1, At, B1); PG8_BAR;
            PG8_LDB(B0, 1, 0); PG8_SCHED; PG8_LDA(At, 1, 0); PG8_STAGE(PG8_SA(0, 1), a2 + hstep, voffA);
            PG8_WAIT_L(8); PG8_BAR; PG8_WAIT_L(0); PG8_MMA(0, 0, At, B0); PG8_BAR; PG8_SCHED;
            PG8_LDB(B1, 1, 1); PG8_STAGE(PG8_SB(1, 0), b3, voffB);
            PG8_BAR; PG8_WAIT_L(0); PG8_MMA(0, 1, At, B1); PG8_BAR;
            PG8_LDA(At, 1, 1); PG8_STAGE(PG8_SA(1, 0), a3, voffA);
            PG8_BAR; PG8_WAIT_L(0); PG8_MMA(1, 0, At, B0); PG8_BAR; PG8_SCHED;
            PG8_STAGE(PG8_SB(1, 1), b3 + hstep, voffB);
            PG8_WAIT_V(6); PG8_BAR; PG8_MMA(1, 1, At, B1); PG8_BAR;
            }
        }
        if constexpr (ALIGN_EPI) { if (wr == 0) PG8_BAR; }
        if constexpr (!Epi::AFTER_DRAIN) { E(acc, cur, wr, wc, fr, fq); S.done(cur); }
        if (!has_next) break;
#pragma unroll
        for (int a = 0; a < 2; ++a)
#pragma unroll
            for (int b = 0; b < 2; ++b)
#pragma unroll
                for (int m = 0; m < 4; ++m)
#pragma unroll
                    for (int n = 0; n < 2; ++n) acc[a][b][m][n] = (f32x4){0.f, 0.f, 0.f, 0.f};
        cur = nxt; cA = nA; cB = nB; ++ui;
        if constexpr (ALIGN_EPI) { if (wr == 1) PG8_BAR; }
    }
    PG8_WAIT_V(0);
    if constexpr (!ALIGN_EPI) { if (wr == 0) PG8_BAR; }
    PG8_BAR;
    if constexpr (Epi::AFTER_DRAIN) { E.fused(acc, cur, wr, wc, fr, fq, lds, wid, lane); S.done(cur); }
#undef PG8_SA
#undef PG8_SB
#undef PG8_STAGE
#undef PG8_LDA
#undef PG8_LDB
#undef PG8_MMA
#undef PG8_WAIT_V
#undef PG8_WAIT_L
#undef PG8_BAR
#undef PG8_SCHED
}
}
#ifndef MK_ONE_LAUNCH
#define MK_ONE_LAUNCH 1
#endif
constexpr int NWAVES = 8, NTHR = 512;
constexpr int DM = 1024, BATCH = 4, SEQ = 4096, MP = BATCH * SEQ, MS = 128, MT = MP + MS, NCH = SEQ / 64;
constexpr int PROJW = 3584, IN_A = 3600, DFF = 2816, ROWW = 304, PASTLEN = 8192, NPAGES = 64;
constexpr int QP = 1536;
constexpr float EPSN = 1e-6f;
constexpr float QSCALE = 0.10206207261596577f * 1.4426950408889634f;
constexpr size_t MiB = 1u << 20;
constexpr size_t WS_CTL = 0, CTL_ZERO_BYTES = 1 * MiB;
constexpr size_t W_INA = 2 * MiB, W_OUTA = 10 * MiB, W_INC = 12 * MiB, W_UQ = 14 * MiB, W_UKV = 16 * MiB, W_OUTC = 18 * MiB, W_GU0 = 20 * MiB, W_GU1 = 32 * MiB, W_DN0 = 44 * MiB, W_DN1 = 50 * MiB;
constexpr size_t A_XN = 64 * MiB, A_GATES = 97 * MiB, A_PROJ = 100 * MiB, A_MIX = 214 * MiB, A_X1 = 248 * MiB, A_H = 314 * MiB, A_X2 = 404 * MiB, A_X3 = 470 * MiB;
constexpr size_t G_UIMG = 536 * MiB, G_WN = 568 * MiB, G_KDT = 584 * MiB, G_QE = 600 * MiB, G_AT = 616 * MiB, G_ELAST = 624 * MiB, G_SCT = 626 * MiB, G_VNT = 658 * MiB;
constexpr size_t S_STATES = 676 * MiB, S_ELAST = 740 * MiB, S_HC = 742 * MiB;
constexpr size_t C_CKV = 776 * MiB, C_CQN = 842 * MiB, C_CN = 860 * MiB, C_KRX = 870 * MiB, C_QRAW = 876 * MiB, C_KN = 926 * MiB, C_VV = 960 * MiB, C_QF = 994 * MiB, C_KF = 1044 * MiB, C_OA = 1094 * MiB;
constexpr size_t D_PART = 1128 * MiB, D_ML = 1144 * MiB, D_QCAT = 1146 * MiB, WS_END = 1150 * MiB;
constexpr size_t O_YP = 0, O_YS = O_YP + (size_t)MP * DM, O_PGDN = O_YS + (size_t)MS * DM, O_PGC = O_PGDN + 4 * 4 * 128 * 128, O_PSSM = O_PGC + 4 * 3 * 1536, O_PSC = O_PSSM + 4 * 8 * 64 * 128,
    O_PROWS = O_PSC + 4 * 3 * 1024, O_SGDN = O_PROWS + (size_t)MP * ROWW, O_SGC = O_SGDN + (size_t)MS * 4 * 128 * 128, O_SSSM = O_SGC + (size_t)MS * 3 * 1536, O_SSC = O_SSSM + (size_t)MS * 8 * 64 * 128,
    O_SROWS = O_SSC + (size_t)MS * 3 * 1024, O_END = O_SROWS + (size_t)MS * ROWW;
static_assert(O_END == 40243200, "output size");
constexpr int CW_BAR = 4096, CW_QATTN = 8192, CW_QDEC = 8256, CW_SSQ = 16384;
constexpr int RING_BYTES = 131072, LDSCTL_OFF = RING_BYTES, MISC_OFF = LDSCTL_OFF + 320, LDS_BYTES = 147456;

#define GAS __attribute__((address_space(1)))
#define LAS __attribute__((address_space(3)))
typedef unsigned short bf16;
typedef unsigned v4u __attribute__((ext_vector_type(4)));
typedef unsigned v2u __attribute__((ext_vector_type(2)));
typedef float f32x4 __attribute__((ext_vector_type(4)));
typedef float f32x16 __attribute__((ext_vector_type(16)));
typedef short bf16x8 __attribute__((ext_vector_type(8)));
typedef short bf16x4 __attribute__((ext_vector_type(4)));
typedef GAS unsigned gu32;
#define RLX_AGENT __ATOMIC_RELAXED, __HIP_MEMORY_SCOPE_AGENT
#define LDS_WAIT() asm volatile("s_waitcnt lgkmcnt(0)" ::: "memory")
#define VM_WAIT() asm volatile("s_waitcnt vmcnt(0)" ::: "memory")
#define MFMA32(a, b, c) __builtin_amdgcn_mfma_f32_32x32x16_bf16((a), (b), (c), 0, 0, 0)
#define MFMA16(a, b, c) __builtin_amdgcn_mfma_f32_16x16x32_bf16((a), (b), (c), 0, 0, 0)
#define MFMA16K16(a, b, c) __builtin_amdgcn_mfma_f32_16x16x16bf16_1k((a), (b), (c), 0, 0, 0)
__device__ __forceinline__ unsigned f2bf(float f) { unsigned u = __builtin_bit_cast(unsigned, f); return (u + 0x7fffu + ((u >> 16) & 1u)) >> 16; }
typedef float f32x2_t __attribute__((ext_vector_type(2))); typedef __bf16 bf16x2_t __attribute__((ext_vector_type(2)));
__device__ __forceinline__ unsigned pk2(float lo, float hi) { f32x2_t v = {lo, hi}; bf16x2_t b = __builtin_convertvector(v, bf16x2_t); return __builtin_bit_cast(unsigned, b); }
__device__ __forceinline__ float bf2f(bf16 b) { return __uint_as_float(((unsigned)b) << 16); }
__device__ __forceinline__ float bflo(unsigned u) { return __uint_as_float(u << 16); }
__device__ __forceinline__ float bfhi(unsigned u) { return __uint_as_float(u & 0xffff0000u); }
__device__ __forceinline__ int crow(int r, int hi) { return (r & 3) + 8 * (r >> 2) + 4 * hi; }
__device__ __forceinline__ float wave_sum(float v) {
#pragma unroll
    for (int o = 1; o < 64; o <<= 1) v += __shfl_xor(v, o);
    return v;
}
__device__ __forceinline__ float softplusf(float x) { return fmaxf(x, 0.f) + log1pf(__expf(-fabsf(x))); }
__device__ __forceinline__ float siluf(float x) { return x / (1.0f + __expf(-x)); }
__device__ __forceinline__ float sigmoidf(float x) { return 1.0f / (1.0f + __expf(-x)); }
__device__ __forceinline__ bf16x8 mk8(unsigned a, unsigned b, unsigned c, unsigned d) { v4u t = {a, b, c, d}; return __builtin_bit_cast(bf16x8, t); }
#define XB_TMO      128
#define XB_XCNT(j)  (256  + 64 * (j))
#define XB_XSUB(j)  (1280 + 64 * (j))
#define XB_XGEN(j)  (2304 + 64 * (j))
#define XB_TOP      3328
#define XB_TOPGEN   3392
#define XCD_BAR_WORDS 3456
#define XB_SPIN_CAP (1u << 18)

__device__ __forceinline__ unsigned xb_ld(unsigned* p)              { return __hip_atomic_load(p, __ATOMIC_RELAXED, __HIP_MEMORY_SCOPE_AGENT); }
__device__ __forceinline__ unsigned xb_add(unsigned* p, unsigned v) { return __hip_atomic_fetch_add(p, v, __ATOMIC_RELAXED, __HIP_MEMORY_SCOPE_AGENT); }
__device__ __forceinline__ unsigned xb_xcc_id() { return (unsigned)__builtin_amdgcn_s_getreg((3 << 11) | 20) & 0xFu; }
#define XB_SPIN(cond, bar) do { unsigned _sp = 0; while (cond) { __builtin_amdgcn_s_sleep(1); \
    if ((++_sp & 255u) == 0u) { if (xb_ld(&(bar)[XB_TMO])) break; if (_sp > XB_SPIN_CAP) { atomicAdd(&(bar)[XB_TMO], 1u); break; } } } } while (0)

struct XcdBarrier {
    unsigned* bar; unsigned x;
    volatile LAS unsigned* st;
};

__device__ __forceinline__ XcdBarrier xcd_barrier_post(unsigned* bar, volatile LAS unsigned* st) {
    XcdBarrier b; b.bar = bar; b.x = xb_xcc_id(); b.st = st;
    if (threadIdx.x == 0) (void)xb_add(&bar[XB_XCNT(b.x)], 1u);
    return b;
}
__device__ __forceinline__ void xcd_barrier_complete(unsigned* bar, unsigned x, unsigned& nloc, unsigned& nx) {
    const unsigned G = gridDim.x * gridDim.y * gridDim.z;
    unsigned sum, cnt, mine, sp = 0u;
    for (;;) {
        sum = 0u; cnt = 0u; mine = 0u;
#pragma unroll
        for (unsigned j = 0; j < 16; ++j) { const unsigned c = xb_ld(&bar[XB_XCNT(j)]); sum += c; cnt += (c > 0u) ? 1u : 0u; mine = (j == x) ? c : mine; }
        if (sum == G) break;
        __builtin_amdgcn_s_sleep(1);
        if ((++sp & 255u) == 0u) { if (xb_ld(&bar[XB_TMO])) break; if (sp > XB_SPIN_CAP) { atomicAdd(&bar[XB_TMO], 1u); break; } }
    }
    nloc = mine > 0u ? mine : 1u; nx = cnt > 0u ? cnt : 1u;
}

__device__ __forceinline__ void xcd_barrier(const XcdBarrier& b) {
    asm volatile("s_waitcnt vmcnt(0)" ::: "memory");
    __syncthreads();
    if (threadIdx.x == 0) {
        unsigned* bar = b.bar;
        __builtin_amdgcn_s_waitcnt(0);
        unsigned nloc = b.st[0], nx = b.st[1];
        if (nloc == 0u) { xcd_barrier_complete(bar, b.x, nloc, nx); b.st[0] = nloc; b.st[1] = nx; }
        const unsigned old = xb_add(&bar[XB_XSUB(b.x)], 1u);
        const unsigned gen = old / nloc;
        if (old + 1u == (gen + 1u) * nloc) {
            __builtin_amdgcn_fence(__ATOMIC_RELEASE, "agent");
            asm volatile("s_waitcnt vmcnt(0)" ::: "memory");
            const unsigned og = xb_add(&bar[XB_TOP], 1u);
            const unsigned tg = og / nx;
            if (og + 1u == (tg + 1u) * nx) xb_add(&bar[XB_TOPGEN], 1u);
            else XB_SPIN(xb_ld(&bar[XB_TOPGEN]) == tg, bar);
            __builtin_amdgcn_fence(__ATOMIC_ACQUIRE, "agent");
            xb_add(&bar[XB_XGEN(b.x)], 1u);
            asm volatile("s_waitcnt vmcnt(0)" ::: "memory");
        } else {
            XB_SPIN(xb_ld(&bar[XB_XGEN(b.x)]) == gen, bar);
            __builtin_amdgcn_fence(__ATOMIC_ACQUIRE, "agent");
            asm volatile("s_waitcnt vmcnt(0)" ::: "memory");
        }
    }
    __syncthreads();
}
struct Args { const float* in[34]; float* out; unsigned char* ws; int ph_lo, ph_hi, flags, pad; };
#define IN_XP 0
#define IN_XS 1
#define IN_SGDN 2
#define IN_SGC 3
#define IN_SSSM 4
#define IN_SSC 5
#define IN_CACHE 6
#define IN_PT 7
#define IN_NORM_A 8
#define IN_W_IN_A 9
#define IN_CONV_GW 10
#define IN_G_ALOG 11
#define IN_G_DTB 12
#define IN_G_NORM 13
#define IN_CONV_SW 14
#define IN_CONV_SB 15
#define IN_S_ALOG 16
#define IN_S_DTB 17
#define IN_S_D 18
#define IN_S_NORM 19
#define IN_W_OUT_A 20
#define IN_NORM_C 21
#define IN_W_IN_C 22
#define IN_QA_NORM 23
#define IN_KVA_NORM 24
#define IN_W_UQ 25
#define IN_W_UK 26
#define IN_W_UV 27
#define IN_Q_NORM 28
#define IN_K_NORM 29
#define IN_W_OUT_C 30
#define IN_NORM_F 31
#define IN_W_GU 32
#define IN_W_DN 33
#define WSP(T, off) ((T*)(a.ws + (off)))

struct Ctx { int tid, lane, wave, bid, G, gw, NGW; };

__device__ __forceinline__ void transpose_block(const float* W, int Nsrc, int K, bf16* WT, int kb, int dst_n0, int src_n0, LAS float* scr, int lane, const float* gain) {
    const int k0 = 64 * kb;
    float wv[32];
#pragma unroll
    for (int i = 0; i < 32; ++i) { const int kk = 2 * i + (lane >> 5); wv[i] = (src_n0 >= 0) ? W[(size_t)(k0 + kk) * Nsrc + src_n0 + (lane & 31)] : 0.f; }
#pragma unroll
    for (int i = 0; i < 32; ++i) { const int kk = 2 * i + (lane >> 5); const float gk = gain ? gain[k0 + kk] : 1.0f; scr[kk * 33 + (lane & 31)] = wv[i] * gk; }
    LDS_WAIT(); asm volatile("" ::: "memory");
    const int c = lane & 7;
#pragma unroll
    for (int j = 0; j < 4; ++j) { const int n = (lane >> 3) + 8 * j; const LAS float* s = scr + (8 * c) * 33 + n;
        v4u o; o.x = pk2(s[0 * 33], s[1 * 33]); o.y = pk2(s[2 * 33], s[3 * 33]); o.z = pk2(s[4 * 33], s[5 * 33]); o.w = pk2(s[6 * 33], s[7 * 33]);
        *(GAS v4u*)(WT + (size_t)(dst_n0 + n) * K + k0 + 8 * c) = o; }
    LDS_WAIT(); asm volatile("" ::: "memory");
}
__device__ __forceinline__ int map_col(int kind, int n) {
    if (kind == 1) return n < 2048 ? n : n + 8;
    if (kind == 2) return n < 800 ? n : -1;
    if (kind == 3) { const int pn = n >> 8, w = n & 255; return w < 128 ? 128 * pn + w : 2816 + 128 * pn + (w - 128); }
    return n;
}
__device__ __forceinline__ bool conv_matrix(int& r, const float* W, int Nsrc, int K, bf16* WT, int Ndst, int kind, LAS float* scr, int lane, const float* gain = nullptr) {
    const int nb32 = Ndst / 32, nblk = (K / 64) * nb32;
    if (r >= nblk) { r -= nblk; return false; }
    const int kb = r / nb32, nb = r % nb32;
    transpose_block(W, Nsrc, K, WT, kb, 32 * nb, map_col(kind, 32 * nb), scr, lane, gain);
    return true;
}
constexpr int blk_of(int K, int N) { return (K / 64) * (N / 32); }
constexpr int P0_NITEMS = blk_of(1024, 3584);
constexpr int LATE0_NITEMS = blk_of(1024, 1024) + blk_of(1024, 5632) + blk_of(2816, 1024);
constexpr int LATE1_NITEMS = blk_of(1024, 1024) * 2 + blk_of(512, 1536) + blk_of(256, 1024) * 2 + blk_of(1024, 5632) + blk_of(2816, 1024);

__device__ __forceinline__ void rms_row_regs(const f32x4 (&v)[4], const float* gain, bf16* orow, int lane, f32x4 (&y)[4]) {
    const GAS f32x4* gr = (const GAS f32x4*)gain + lane; float s = 0.f;
#pragma unroll
    for (int j = 0; j < 4; ++j) s += (v[j].x * v[j].x + v[j].y * v[j].y) + (v[j].z * v[j].z + v[j].w * v[j].w);
    const float rstd = rsqrtf(wave_sum(s) * (1.f / 1024.f) + EPSN);
    GAS v2u* o8 = (GAS v2u*)orow + lane;
#pragma unroll
    for (int j = 0; j < 4; ++j) { const f32x4 g = gr[64 * j]; y[j] = v[j] * rstd * g; v2u o; o.x = pk2(y[j].x, y[j].y); o.y = pk2(y[j].z, y[j].w); o8[64 * j] = o; }
}
__device__ __forceinline__ void rms_row(const float* xrow, const float* gain, bf16* orow, int lane, f32x4 (&y)[4]) {
    const GAS f32x4* xr = (const GAS f32x4*)xrow + lane; f32x4 v[4];
#pragma unroll
    for (int j = 0; j < 4; ++j) v[j] = xr[64 * j];
    rms_row_regs(v, gain, orow, lane, y);
}
__device__ __forceinline__ void ph_rmsnorm(const Args& a, const Ctx& c, const float* X, const float* gain) {
    bf16* XN = WSP(bf16, A_XN);
    for (int m = c.gw; m < MT; m += c.NGW) { f32x4 y[4]; rms_row(X + (size_t)m * DM, gain, XN + (size_t)m * DM, c.lane, y); }
}
__device__ __forceinline__ void ph_prologue(const Args& a, const Ctx& c, unsigned char* lds) {
    LAS float* scr = (LAS float*)((LAS unsigned char*)lds + c.wave * 16384);
    for (int it = c.gw; it < P0_NITEMS; it += c.NGW) { int r = it; conv_matrix(r, a.in[IN_W_IN_A], IN_A, 1024, WSP(bf16, W_INA), PROJW, 1, scr, c.lane); }
    __syncthreads();
    float* Wg = (float*)lds;
    for (int i = c.tid; i < 1024 * 4; i += NTHR) { const int k = i >> 2, q = i & 3; const int col = (q < 2) ? 2048 + 4 * q : 3592 + 4 * (q - 2);
        const f32x4 w = *(const f32x4*)(a.in[IN_W_IN_A] + (size_t)k * IN_A + col);
        Wg[(4 * q) * 1024 + k] = w.x; Wg[(4 * q + 1) * 1024 + k] = w.y; Wg[(4 * q + 2) * 1024 + k] = w.z; Wg[(4 * q + 3) * 1024 + k] = w.w; }
    __syncthreads();
    bf16* XN = WSP(bf16, A_XN); float* GATES = WSP(float, A_GATES);
    f32x4 xcur[4];
    if (c.gw < MT) { const int m0 = c.gw; const GAS f32x4* xr = (const GAS f32x4*)((m0 < MP) ? a.in[IN_XP] + (size_t)m0 * DM : a.in[IN_XS] + (size_t)(m0 - MP) * DM) + c.lane;
#pragma unroll
        for (int j = 0; j < 4; ++j) xcur[j] = xr[64 * j]; }
    for (int m = c.gw; m < MT; m += c.NGW) {
        f32x4 xnxt[4]; const int mn = m + c.NGW;
#pragma unroll
        for (int j = 0; j < 4; ++j) xnxt[j] = xcur[j];
        if (mn < MT) { const GAS f32x4* xr = (const GAS f32x4*)((mn < MP) ? a.in[IN_XP] + (size_t)mn * DM : a.in[IN_XS] + (size_t)(mn - MP) * DM) + c.lane;
#pragma unroll
            for (int j = 0; j < 4; ++j) xnxt[j] = xr[64 * j]; }
        f32x4 y[4]; rms_row_regs(xcur, a.in[IN_NORM_A], XN + (size_t)m * DM, c.lane, y);
#pragma unroll
        for (int j = 0; j < 4; ++j) xcur[j] = xnxt[j];
        float g[16];
#pragma unroll
        for (int q = 0; q < 16; ++q) g[q] = 0.f;
#pragma unroll
        for (int q = 0; q < 16; ++q) {
#pragma unroll
            for (int j = 0; j < 4; ++j) { const f32x4 w = *(const f32x4*)(Wg + q * 1024 + 4 * c.lane + 256 * j); g[q] += (y[j].x * w.x + y[j].y * w.y) + (y[j].z * w.z + y[j].w * w.w); }
            if ((q & 3) == 3) asm volatile("" ::: "memory"); }
#pragma unroll
        for (int q = 0; q < 16; ++q) g[q] = wave_sum(g[q]);
        float mine = 0.f;
#pragma unroll
        for (int q = 0; q < 16; ++q) mine = (c.lane == q) ? g[q] : mine;
        if (c.lane < 16) GATES[(size_t)m * 16 + c.lane] = mine;
    }
    __syncthreads();
}

template <int LAYER> __device__ __forceinline__ void ph_late_weights(const Args& a, const Ctx& c, unsigned char* lds, int wv, int nwv) {
    LAS float* scr = (LAS float*)((LAS unsigned char*)lds + c.wave * 16384);
    for (int it = wv; it < (LAYER == 0 ? LATE0_NITEMS : LATE1_NITEMS); it += nwv) {
        int r = it;
        if (LAYER == 0) {
            if (conv_matrix(r, a.in[IN_W_OUT_A], 1024, 1024, WSP(bf16, W_OUTA), 1024, 0, scr, c.lane)) continue;
            if (conv_matrix(r, a.in[IN_W_GU], 5632, 1024, WSP(bf16, W_GU0), 5632, 3, scr, c.lane, a.in[IN_NORM_F])) continue;
            conv_matrix(r, a.in[IN_W_DN], 1024, 2816, WSP(bf16, W_DN0), 1024, 0, scr, c.lane);
        } else {
            if (conv_matrix(r, a.in[IN_W_IN_C], 800, 1024, WSP(bf16, W_INC), 1024, 2, scr, c.lane, a.in[IN_NORM_C])) continue;
            if (conv_matrix(r, a.in[IN_W_UQ], 1536, 512, WSP(bf16, W_UQ), 1536, 0, scr, c.lane, a.in[IN_QA_NORM])) continue;
            if (conv_matrix(r, a.in[IN_W_UK], 1024, 256, WSP(bf16, W_UKV), 1024, 0, scr, c.lane, a.in[IN_KVA_NORM])) continue;
            if (conv_matrix(r, a.in[IN_W_UV], 1024, 256, WSP(bf16, W_UKV) + 1024 * 256, 1024, 0, scr, c.lane, a.in[IN_KVA_NORM])) continue;
            if (conv_matrix(r, a.in[IN_W_OUT_C], 1024, 1024, WSP(bf16, W_OUTC), 1024, 0, scr, c.lane)) continue;
            if (conv_matrix(r, a.in[IN_W_GU] + (size_t)1024 * 5632, 5632, 1024, WSP(bf16, W_GU1), 5632, 3, scr, c.lane, a.in[IN_NORM_F] + DM)) continue;
            conv_matrix(r, a.in[IN_W_DN] + (size_t)2816 * 1024, 1024, 2816, WSP(bf16, W_DN1), 1024, 0, scr, c.lane);
        }
    }
}

template <class F> __device__ __forceinline__ void small_gemm(const Ctx& c, const bf16* A, int lda, const bf16* Bt, int K, int nct, const F& epi) {
    const int l15 = c.lane & 15, kq = c.lane >> 4;
    for (int it = c.gw; it < 8 * nct; it += c.NGW) { const int rt = it & 7, ct = it >> 3;
        const bf16* ap = A + (size_t)(16 * rt + l15) * lda + 8 * kq; const bf16* bp = Bt + (size_t)(16 * ct + l15) * K + 8 * kq;
        f32x4 acc = {0.f, 0.f, 0.f, 0.f}, acc2 = {0.f, 0.f, 0.f, 0.f};
        for (int k0 = 0; k0 < K; k0 += 256) { bf16x8 av[8], bv[8];
#pragma unroll
            for (int j = 0; j < 8; ++j) { av[j] = *(const GAS bf16x8*)(ap + k0 + 32 * j); bv[j] = *(const GAS bf16x8*)(bp + k0 + 32 * j); }
#pragma unroll
            for (int j = 0; j < 8; j += 2) { acc = MFMA16(av[j], bv[j], acc); acc2 = MFMA16(av[j + 1], bv[j + 1], acc2); } }
        acc = acc + acc2;
#pragma unroll
        for (int r = 0; r < 4; ++r) epi(16 * rt + 4 * kq + r, 16 * ct + l15, acc[r]);
    }
}
template <class F> __device__ __forceinline__ void small_gemm_glu(const Ctx& c, const bf16* A, int lda, const bf16* Bt, int K, const float* ssq, const F& epi) {
    const int l15 = c.lane & 15, kq = c.lane >> 4;
    for (int it = c.gw; it < 8 * (DFF / 16); it += c.NGW) { const int rt = it & 7, ct = it >> 3; const int n = 16 * ct + l15; const int grow = 256 * (n >> 7) + (n & 127);
        const bf16* ap = A + (size_t)(16 * rt + l15) * lda + 8 * kq; const bf16* gp = Bt + (size_t)grow * K + 8 * kq; const bf16* up = gp + (size_t)128 * K;
        f32x4 ag = {0.f, 0.f, 0.f, 0.f}, au = {0.f, 0.f, 0.f, 0.f};
#pragma unroll 8
        for (int k = 0; k < K; k += 32) { const bf16x8 av = *(const GAS bf16x8*)(ap + k), gv = *(const GAS bf16x8*)(gp + k), uv = *(const GAS bf16x8*)(up + k); ag = MFMA16(av, gv, ag); au = MFMA16(av, uv, au); }
#pragma unroll
        for (int r = 0; r < 4; ++r) { const float rs = rsqrtf(ssq[16 * rt + 4 * kq + r] * (1.f / 1024.f) + EPSN); epi(16 * rt + 4 * kq + r, n, siluf(ag[r] * rs) * (au[r] * rs)); }
    }
}
struct SEpiBf16 { bf16* O; int ldo; __device__ __forceinline__ void operator()(int m, int n, float v) const { O[(size_t)m * ldo + n] = (bf16)f2bf(v); } };
struct SEpiF32 { float* O; int ldo; const float* ssq; __device__ __forceinline__ void operator()(int m, int n, float v) const { O[(size_t)m * ldo + n] = v * rsqrtf(ssq[m] * (1.f / 1024.f) + EPSN); } };
struct SEpiRes { const float* Rf; const bf16* Rb; int ldo; bf16* XN; float* ssq; float* Yf;
    __device__ __forceinline__ void operator()(int m, int n, float v) const { const size_t o = (size_t)m * ldo + n; const float x = (Rf ? Rf[o] : bf2f(Rb[o])) + v;
        if (Yf) Yf[o] = x;
        if (XN) { XN[o] = (bf16)f2bf(x); float sq = x * x; sq += __shfl_xor(sq, 1); sq += __shfl_xor(sq, 2); sq += __shfl_xor(sq, 4); sq += __shfl_xor(sq, 8); if ((n & 15) == 0) atomicAdd(ssq + m, sq); } } };
struct SEpiBf16Rs { bf16* O; int ldo; const float* ssq; float inv_n; __device__ __forceinline__ void operator()(int m, int n, float v) const { O[(size_t)m * ldo + n] = (bf16)f2bf(v * rsqrtf(ssq[m] * inv_n + EPSN)); } };
struct SEpiInC { float* C; const float* ssq_x; bf16* CQ; bf16* CK; float* ssq_q; float* ssq_c;
    __device__ __forceinline__ void operator()(int m, int n, float v) const { const float x = v * rsqrtf(ssq_x[m] * (1.f / 1024.f) + EPSN);
        if (n >= 512) C[(size_t)m * DM + n] = x;
        if (n < 768) { if (n < 512) CQ[(size_t)m * 512 + n] = (bf16)f2bf(x); else CK[(size_t)m * 256 + (n - 512)] = (bf16)f2bf(x); }
        float sq = (n < 768) ? x * x : 0.f; sq += __shfl_xor(sq, 1); sq += __shfl_xor(sq, 2); sq += __shfl_xor(sq, 4); sq += __shfl_xor(sq, 8);
        if ((n & 15) == 0 && n < 768) atomicAdd((n < 512 ? ssq_q : ssq_c) + m, sq); } };
__device__ __forceinline__ int invperm16(int k) { return 8 * ((k >> 2) & 1) + 4 * (k >> 3) + (k & 3); }
__device__ __forceinline__ void g1_item(const Args& a, const Ctx& c, unsigned char* lds, int item) {
    const int b = item >> 8, h = (item >> 6) & 3, ch = item & 63, row0 = b * SEQ + ch * 64;
    bf16* Qs = (bf16*)lds; bf16* Ks = (bf16*)(lds + 17408); bf16* Vs = (bf16*)(lds + 34816);
    float* Am = (float*)(lds + 52224); float* cumv = (float*)(lds + 68608); float* betav = cumv + 64; float* ecum = cumv + 128; float* edec = cumv + 192;
    const bf16* PROJ = WSP(bf16, A_PROJ); const float* GATES = WSP(float, A_GATES);
    const float* cw = a.in[IN_CONV_GW];
    float* cwl = (float*)(lds + 69632);
    for (int q = c.tid; q < 1536; q += NTHR) { const int tap = q / 384, r = q - tap * 384, X = r >> 7, d = r & 127; cwl[q] = cw[tap * 1536 + X * 512 + h * 128 + d]; }
    __syncthreads();
    { const int i = c.tid >> 3, g8 = c.tid & 7, t = ch * 64 + i;
#pragma unroll
      for (int X = 0; X < 3; ++X) {
        const int ch0 = X * 512 + h * 128 + g8 * 16;
        float acc[16];
#pragma unroll
        for (int e = 0; e < 16; ++e) acc[e] = 0.f;
        v4u xa[4], xb[4];
#pragma unroll
        for (int tap = 0; tap < 4; ++tap) { const int tt = t - 3 + tap; const bf16* src = PROJ + (size_t)(b * SEQ + (tt >= 0 ? tt : 0)) * PROJW + ch0; xa[tap] = *(const GAS v4u*)src; xb[tap] = *(const GAS v4u*)(src + 8); }
#pragma unroll
        for (int tap = 0; tap < 4; ++tap) { const int tt = t - 3 + tap; const float ok = (tt >= 0) ? 1.0f : 0.0f; const v4u x0 = xa[tap], x1 = xb[tap];
            { const float* wp = cwl + tap * 384 + X * 128 + g8 * 16; const f32x4 w0 = *(const f32x4*)wp * ok, w1 = *(const f32x4*)(wp + 4) * ok, w2 = *(const f32x4*)(wp + 8) * ok, w3 = *(const f32x4*)(wp + 12) * ok;
                acc[0] += w0.x * bflo(x0.x); acc[1] += w0.y * bfhi(x0.x); acc[2] += w0.z * bflo(x0.y); acc[3] += w0.w * bfhi(x0.y);
                acc[4] += w1.x * bflo(x0.z); acc[5] += w1.y * bfhi(x0.z); acc[6] += w1.z * bflo(x0.w); acc[7] += w1.w * bfhi(x0.w);
                acc[8] += w2.x * bflo(x1.x); acc[9] += w2.y * bfhi(x1.x); acc[10] += w2.z * bflo(x1.y); acc[11] += w2.w * bfhi(x1.y);
                acc[12] += w3.x * bflo(x1.z); acc[13] += w3.y * bfhi(x1.z); acc[14] += w3.z * bflo(x1.w); acc[15] += w3.w * bfhi(x1.w); } }
        float ssq = 0.f;
#pragma unroll
        for (int e = 0; e < 16; ++e) { acc[e] = siluf(acc[e]); ssq += acc[e] * acc[e]; }
        if (X < 2) { ssq += __shfl_xor(ssq, 1); ssq += __shfl_xor(ssq, 2); ssq += __shfl_xor(ssq, 4);
            const float rn = rsqrtf(ssq + EPSN) * (X == 0 ? 0.08838834764831845f : 1.0f);
#pragma unroll
            for (int e = 0; e < 16; ++e) acc[e] *= rn; }
        bf16* dst = (X == 0 ? Qs : (X == 1 ? Ks : Vs)) + i * 136 + g8 * 16;
        v4u o0, o1; o0.x = pk2(acc[0], acc[1]); o0.y = pk2(acc[2], acc[3]); o0.z = pk2(acc[4], acc[5]); o0.w = pk2(acc[6], acc[7]);
        o1.x = pk2(acc[8], acc[9]); o1.y = pk2(acc[10], acc[11]); o1.z = pk2(acc[12], acc[13]); o1.w = pk2(acc[14], acc[15]);
        *(v4u*)dst = o0; *(v4u*)(dst + 8) = o1;
      } }
    if (c.wave == 0) { const int i = c.lane; const float* gp = GATES + (size_t)(row0 + i) * 16;
        const float g = -__expf(a.in[IN_G_ALOG][h]) * softplusf(gp[h] + a.in[IN_G_DTB][h]); const float beta = sigmoidf(gp[4 + h]);
        float cs = g;
#pragma unroll
        for (int o = 1; o < 64; o <<= 1) { const float t2 = __shfl_up(cs, o); if (c.lane >= o) cs += t2; }
        const float last = __shfl(cs, 63);
        cumv[i] = cs; betav[i] = beta; ecum[i] = __expf(cs); edec[i] = __expf(last - cs);
        if (c.lane == 0) WSP(float, G_ELAST)[item] = __expf(last); }
    __syncthreads();
    { const int q = c.wave & 3, ti = q & 1, tj = q >> 1, r32 = c.lane & 31, hi = c.lane >> 5; const bool isKK = c.wave < 4;
      f32x16 acc;
#pragma unroll
      for (int r = 0; r < 16; ++r) acc[r] = 0.f;
      if (ti >= tj) { const bf16* Xa = (isKK ? Ks : Qs) + (32 * ti + r32) * 136 + 8 * hi; const bf16* Xb = Ks + (32 * tj + r32) * 136 + 8 * hi;
#pragma unroll
          for (int kk = 0; kk < 8; ++kk) { const bf16x8 av = *(const bf16x8*)(Xa + 16 * kk), bv = *(const bf16x8*)(Xb + 16 * kk); acc = MFMA32(av, bv, acc); } }
      const int j = 32 * tj + r32; const float cj = cumv[j]; bf16* AT = WSP(bf16, G_AT) + (size_t)item * 4096;
#pragma unroll
      for (int r = 0; r < 16; ++r) { const int i = 32 * ti + crow(r, hi);
          if (isKK) { const float e = (i > j) ? __expf(cumv[i] - cj) * betav[i] : 0.f; Am[i * 64 + j] = acc[r] * e; }
          else { const float e = (i >= j) ? __expf(cumv[i] - cj) : 0.f; AT[i * 64 + 16 * (j >> 4) + invperm16(j & 15)] = (bf16)f2bf(acc[r] * e); } } }
    { const int i = c.tid >> 3, g8 = c.tid & 7; const float e = ecum[i]; const bf16* s = Qs + i * 136 + g8 * 16; const v4u x0 = *(const v4u*)s, x1 = *(const v4u*)(s + 8);
      v4u o0, o1; o0.x = pk2(bflo(x0.x) * e, bfhi(x0.x) * e); o0.y = pk2(bflo(x0.y) * e, bfhi(x0.y) * e); o0.z = pk2(bflo(x0.z) * e, bfhi(x0.z) * e); o0.w = pk2(bflo(x0.w) * e, bfhi(x0.w) * e);
      o1.x = pk2(bflo(x1.x) * e, bfhi(x1.x) * e); o1.y = pk2(bflo(x1.y) * e, bfhi(x1.y) * e); o1.z = pk2(bflo(x1.z) * e, bfhi(x1.z) * e); o1.w = pk2(bflo(x1.w) * e, bfhi(x1.w) * e);
      bf16* dst = WSP(bf16, G_QE) + (size_t)item * 8192 + i * 128 + g8 * 16;
      const v4u q0 = {o0.x, o0.y, o1.x, o1.y}, q1 = {o0.z, o0.w, o1.z, o1.w};
      *(GAS v4u*)dst = q0; *(GAS v4u*)(dst + 8) = q1; }
#pragma unroll
    for (int rep = 0; rep < 2; ++rep) { const int idx = c.tid + 512 * rep, d = idx >> 3, ig = idx & 7; float v[8];
#pragma unroll
        for (int jj = 0; jj < 8; ++jj) { const int i = 16 * (ig >> 1) + 8 * (jj >> 2) + 4 * (ig & 1) + (jj & 3); v[jj] = bf2f(Ks[i * 136 + d]) * edec[i]; }
        v4u o; o.x = pk2(v[0], v[1]); o.y = pk2(v[2], v[3]); o.z = pk2(v[4], v[5]); o.w = pk2(v[6], v[7]);
        *(GAS v4u*)(WSP(bf16, G_KDT) + (size_t)item * 8192 + d * 64 + 8 * ig) = o; }
    __syncthreads();
    float x[64];
#pragma unroll
    for (int i = 0; i < 64; ++i) x[i] = 0.f;
    if (c.tid < 256) { const bool isU = c.tid < 128; const int d = c.tid & 127; const bf16* Xs_ = isU ? Vs : Ks;
#pragma unroll
        for (int i = 0; i < 64; ++i) { float rhs = bf2f(Xs_[i * 136 + d]) * betav[i]; if (!isU) rhs *= ecum[i];
            const float* Ar = Am + i * 64;
            float s1 = 0.f, s2 = 0.f, s3 = 0.f;
#pragma unroll
            for (int j4 = 0; j4 < i; j4 += 4) { const f32x4 av = *(const f32x4*)(Ar + j4);
                rhs -= av.x * x[j4]; if (j4 + 1 < i) s1 -= av.y * x[j4 + 1]; if (j4 + 2 < i) s2 -= av.z * x[j4 + 2]; if (j4 + 3 < i) s3 -= av.w * x[j4 + 3]; }
            rhs = (rhs + s1) + (s2 + s3);
            asm volatile("" : "+v"(rhs) :: "memory"); x[i] = rhs; } }
    __syncthreads();
    bf16* Uimg = (bf16*)lds; bf16* Wimg = (bf16*)(lds + 32768);
    if (c.tid < 128) { const int d = c.tid, slice = d >> 5, col = d & 31;
#pragma unroll
        for (int i = 0; i < 64; ++i) { const int rt = i >> 5, ri = i & 31, hi_ = (ri >> 2) & 1, r = (ri & 3) + 4 * (ri >> 3); Uimg[((slice * 2 + rt) * 64 + col + 32 * hi_) * 16 + r] = (bf16)f2bf(x[i]); } }
    else if (c.tid < 256) { const int d = c.tid - 128, pos = 16 * (d >> 4) + invperm16(d & 15);
#pragma unroll
        for (int i = 0; i < 64; ++i) Wimg[i * 128 + pos] = (bf16)f2bf(-x[i]); }
    __syncthreads();
    { bf16* Ug = WSP(bf16, G_UIMG) + (size_t)item * 8192; bf16* Wg = WSP(bf16, G_WN) + (size_t)item * 8192;
#pragma unroll
      for (int k = 0; k < 2; ++k) { const int q = c.tid + 512 * k; *(GAS v4u*)(Ug + 8 * q) = *(const v4u*)(Uimg + 8 * q); *(GAS v4u*)(Wg + 8 * q) = *(const v4u*)(Wimg + 8 * q); } }
    __syncthreads();
}

constexpr int G2_SLOT = 35840, G2_KD = 17408;
__device__ __forceinline__ void g2_block(const Args& a, const Ctx& c, unsigned char* lds, int bh) {
    const bf16* Ug = WSP(bf16, G_UIMG); const bf16* Wn = WSP(bf16, G_WN); const bf16* Kd = WSP(bf16, G_KDT); const float* El = WSP(float, G_ELAST);
    bf16* SCt = WSP(bf16, G_SCT); bf16* VNt = WSP(bf16, G_VNT);
    const int lane = c.lane, r32 = lane & 31, hi = lane >> 5;
#define G2_BAR() do { LDS_WAIT(); __builtin_amdgcn_s_barrier(); asm volatile("" ::: "memory"); } while (0)
    if (c.wave >= 4) {
        const int hl = (c.wave - 4) * 64 + lane;
        int wo[4], ko[4];
#pragma unroll
        for (int k = 0; k < 4; ++k) { const int p = hl + 256 * k; wo[k] = (p >> 4) * 272 + (p & 15) * 16; ko[k] = G2_KD + (p >> 3) * 144 + (p & 7) * 16; }
        v4u r0w[4], r0k[4], r1w[4], r1k[4], r2w[4], r2k[4], r3w[4], r3k[4];
#define G2_LOAD(RW, RK, ch) do { const size_t it_ = ((size_t)bh * 64 + (ch)) * 8192; _Pragma("unroll") for (int k = 0; k < 4; ++k) { RW[k] = *(const GAS v4u*)(Wn + it_ + (size_t)(hl + 256 * k) * 8); RK[k] = *(const GAS v4u*)(Kd + it_ + (size_t)(hl + 256 * k) * 8); } } while (0)
#define G2_PUT(RW, RK, slot) do { unsigned char* sb_ = lds + (slot) * G2_SLOT; _Pragma("unroll") for (int k = 0; k < 4; ++k) { *(v4u*)(sb_ + wo[k]) = RW[k]; *(v4u*)(sb_ + ko[k]) = RK[k]; } } while (0)
        G2_LOAD(r0w, r0k, 0); G2_LOAD(r1w, r1k, 1); G2_LOAD(r2w, r2k, 2); G2_LOAD(r3w, r3k, 3);
        G2_PUT(r0w, r0k, 0); G2_LOAD(r0w, r0k, 4);
        G2_PUT(r1w, r1k, 1); G2_LOAD(r1w, r1k, 5);
        G2_BAR();
        int slot = 2;
#define G2_MOVE(RW, RK, chp) do { if ((chp) + 2 < NCH) { G2_PUT(RW, RK, slot); if ((chp) + 6 < NCH) G2_LOAD(RW, RK, (chp) + 6); } slot = (slot == 2) ? 0 : slot + 1; G2_BAR(); } while (0)
        for (int ch = 0; ch < NCH; ch += 4) { G2_MOVE(r2w, r2k, ch); G2_MOVE(r3w, r3k, ch + 1); G2_MOVE(r0w, r0k, ch + 2); G2_MOVE(r1w, r1k, ch + 3); }
#undef G2_MOVE
#undef G2_LOAD
#undef G2_PUT
        return;
    }
    const int slice = c.wave;
    float* els = (float*)(lds + 3 * G2_SLOT);
    if (c.wave == 0) els[lane] = El[(size_t)bh * 64 + lane];
    f32x16 S[4];
#pragma unroll
    for (int t = 0; t < 4; ++t)
#pragma unroll
        for (int r = 0; r < 16; ++r) S[t][r] = 0.f;
    v4u ua[4], ub[4];
#define G2_ULOAD(UN, ch) do { const bf16* up_ = Ug + ((size_t)bh * 64 + (ch)) * 8192 + (size_t)(slice * 2 * 64 + lane) * 16; UN[0] = *(const GAS v4u*)(up_); UN[1] = *(const GAS v4u*)(up_ + 8); UN[2] = *(const GAS v4u*)(up_ + 1024); UN[3] = *(const GAS v4u*)(up_ + 1032); } while (0)
#define G2_STEP(UN, ch) do { const size_t item = (size_t)bh * 64 + (ch); const unsigned char* sb = lds + slot * G2_SLOT; \
        f32x16 av[2]; \
        _Pragma("unroll") for (int rt = 0; rt < 2; ++rt) _Pragma("unroll") for (int q = 0; q < 2; ++q) { const v4u uu = UN[2 * rt + q]; av[rt][8 * q] = bflo(uu.x); av[rt][8 * q + 1] = bfhi(uu.x); av[rt][8 * q + 2] = bflo(uu.y); av[rt][8 * q + 3] = bfhi(uu.y); av[rt][8 * q + 4] = bflo(uu.z); av[rt][8 * q + 5] = bfhi(uu.z); av[rt][8 * q + 6] = bflo(uu.w); av[rt][8 * q + 7] = bfhi(uu.w); } \
        if ((ch) + 2 < NCH) G2_ULOAD(UN, (ch) + 2); \
        const float el = els[(ch)]; \
        bf16* scp = SCt + item * 16384 + (size_t)(slice * 8 * 64 + lane) * 8;     \
        _Pragma("unroll") for (int t = 0; t < 4; ++t) _Pragma("unroll") for (int s2 = 0; s2 < 2; ++s2) { const int o = 8 * s2; \
                const unsigned p0 = pk2(S[t][o], S[t][o + 1]), p1 = pk2(S[t][o + 2], S[t][o + 3]), p2 = pk2(S[t][o + 4], S[t][o + 5]), p3 = pk2(S[t][o + 6], S[t][o + 7]); \
                const bf16x8 sbf = mk8(p0, p1, p2, p3); v4u sw = {p0, p1, p2, p3}; \
                *(GAS v4u*)(scp + (2 * t + s2) * 512) = sw; \
                const bf16x8 w0 = *(const bf16x8*)(sb + (r32) * 272 + (16 * (2 * t + s2) + 8 * hi) * 2), w1 = *(const bf16x8*)(sb + (32 + r32) * 272 + (16 * (2 * t + s2) + 8 * hi) * 2); \
                av[0] = MFMA32(w0, sbf, av[0]); av[1] = MFMA32(w1, sbf, av[1]); } \
        bf16x8 vb[2][2]; bf16* vnp = VNt + item * 8192 + (size_t)(slice * 4 * 64 + lane) * 8;     \
        _Pragma("unroll") for (int rt = 0; rt < 2; ++rt) _Pragma("unroll") for (int s2 = 0; s2 < 2; ++s2) { const int o = 8 * s2; \
                const unsigned p0 = pk2(av[rt][o], av[rt][o + 1]), p1 = pk2(av[rt][o + 2], av[rt][o + 3]), p2 = pk2(av[rt][o + 4], av[rt][o + 5]), p3 = pk2(av[rt][o + 6], av[rt][o + 7]); \
                vb[rt][s2] = mk8(p0, p1, p2, p3); v4u vw = {p0, p1, p2, p3}; \
                *(GAS v4u*)(vnp + (2 * rt + s2) * 512) = vw; } \
        _Pragma("unroll") for (int t = 0; t < 4; ++t) { \
            _Pragma("unroll") for (int r = 0; r < 16; ++r) S[t][r] *= el; \
            _Pragma("unroll") for (int ks = 0; ks < 4; ++ks) { const bf16x8 kf = *(const bf16x8*)(sb + G2_KD + (32 * t + r32) * 144 + (16 * ks + 8 * hi) * 2); S[t] = MFMA32(kf, vb[ks >> 1][ks & 1], S[t]); } } \
        slot = (slot == 2) ? 0 : slot + 1; \
        G2_BAR(); } while (0)
    G2_ULOAD(ua, 0); G2_ULOAD(ub, 1);
    G2_BAR();
    int slot = 0;
    for (int ch = 0; ch < NCH; ch += 2) { G2_STEP(ua, ch); G2_STEP(ub, ch + 1); }
#undef G2_STEP
#undef G2_ULOAD
#undef G2_BAR
    float* og = a.out + O_PGDN + (size_t)bh * 16384;
#pragma unroll
    for (int t = 0; t < 4; ++t)
#pragma unroll
        for (int r = 0; r < 16; ++r) og[(32 * t + crow(r, hi)) * 128 + 32 * slice + r32] = S[t][r];
}

__device__ __forceinline__ void g3_item(const Args& a, const Ctx& c, unsigned char* lds, int item) {
    const int b = item >> 8, h = (item >> 6) & 3, ch = item & 63, row0 = b * SEQ + ch * 64;
    const int rt = c.wave & 1, ct = c.wave >> 1, r32 = c.lane & 31, hi = c.lane >> 5;
    const bf16* qe = WSP(bf16, G_QE) + (size_t)item * 8192 + (32 * rt + r32) * 128 + 8 * hi;
    const bf16* sc = WSP(bf16, G_SCT) + (size_t)item * 16384 + (size_t)(ct * 8 * 64 + c.lane) * 8;
    const bf16* at = WSP(bf16, G_AT) + (size_t)item * 4096 + (32 * rt + r32) * 64 + 8 * hi;
    const bf16* vn = WSP(bf16, G_VNT) + (size_t)item * 8192 + (size_t)(ct * 4 * 64 + c.lane) * 8;
    f32x16 acc;
#pragma unroll
    for (int r = 0; r < 16; ++r) acc[r] = 0.f;
#pragma unroll
    for (int kk = 0; kk < 8; ++kk) { const bf16x8 av = *(const GAS bf16x8*)(qe + 16 * kk), bv = *(const GAS bf16x8*)(sc + 512 * kk); acc = MFMA32(av, bv, acc); }
#pragma unroll
    for (int kk = 0; kk < 4; ++kk) { const bf16x8 av = *(const GAS bf16x8*)(at + 16 * kk), bv = *(const GAS bf16x8*)(vn + 512 * kk); acc = MFMA32(av, bv, acc); }
    float* Ot = (float*)lds;
#pragma unroll
    for (int r = 0; r < 16; ++r) Ot[(32 * rt + crow(r, hi)) * 132 + 32 * ct + r32] = acc[r];
    __syncthreads();
    { const int i = c.tid >> 3, p8 = c.tid & 7; const float* orow = Ot + i * 132 + p8 * 16; float v[16]; float ssq = 0.f;
#pragma unroll
      for (int q = 0; q < 4; ++q) { const f32x4 t4 = *(const f32x4*)(orow + 4 * q); v[4 * q] = t4.x; v[4 * q + 1] = t4.y; v[4 * q + 2] = t4.z; v[4 * q + 3] = t4.w; }
#pragma unroll
      for (int e = 0; e < 16; ++e) ssq += v[e] * v[e];
      ssq += __shfl_xor(ssq, 1); ssq += __shfl_xor(ssq, 2); ssq += __shfl_xor(ssq, 4);
      const float rstd = rsqrtf(ssq * (1.f / 128.f) + EPSN);
      const bf16* zp = WSP(bf16, A_PROJ) + (size_t)(row0 + i) * PROJW + 1536 + h * 128 + p8 * 16; const v4u z0 = *(const GAS v4u*)zp, z1 = *(const GAS v4u*)(zp + 8);
      const float* gn = a.in[IN_G_NORM] + p8 * 16; float z[16];
      z[0] = bflo(z0.x); z[1] = bfhi(z0.x); z[2] = bflo(z0.y); z[3] = bfhi(z0.y); z[4] = bflo(z0.z); z[5] = bfhi(z0.z); z[6] = bflo(z0.w); z[7] = bfhi(z0.w);
      z[8] = bflo(z1.x); z[9] = bfhi(z1.x); z[10] = bflo(z1.y); z[11] = bfhi(z1.y); z[12] = bflo(z1.z); z[13] = bfhi(z1.z); z[14] = bflo(z1.w); z[15] = bfhi(z1.w);
#pragma unroll
      for (int e = 0; e < 16; ++e) v[e] = v[e] * rstd * gn[e] * siluf(z[e]);
      v4u o0, o1; o0.x = pk2(v[0], v[1]); o0.y = pk2(v[2], v[3]); o0.z = pk2(v[4], v[5]); o0.w = pk2(v[6], v[7]); o1.x = pk2(v[8], v[9]); o1.y = pk2(v[10], v[11]); o1.z = pk2(v[12], v[13]); o1.w = pk2(v[14], v[15]);
      bf16* dst = WSP(bf16, A_MIX) + (size_t)(row0 + i) * DM + h * 128 + p8 * 16; *(GAS v4u*)dst = o0; *(GAS v4u*)(dst + 8) = o1; }
    __syncthreads();
}
constexpr int SS_XT = 0, SS_B = 36864, SS_C = 54272, SS_DT = 71680, SS_CUM = 72704, SS_EDEC = 73728, SS_ECUM = 74752, SS_END = 75776;
template <int MODE> __device__ __forceinline__ void ssd_load(const Args& a, const Ctx& c, unsigned char* lds, int item) {
    const int b = item >> 7, grp = (item >> 6) & 1, ch = item & 63, row0 = b * SEQ + ch * 64;
    float* dtv = (float*)(lds + SS_DT); float* cumv = (float*)(lds + SS_CUM); float* edec = (float*)(lds + SS_EDEC); float* ecum = (float*)(lds + SS_ECUM);
    const float* GATES = WSP(float, A_GATES);
    if (c.wave < 4) { const int hd = grp * 4 + c.wave, i = c.lane;
        const float dt = softplusf(GATES[(size_t)(row0 + i) * 16 + 8 + hd] + a.in[IN_S_DTB][hd]); const float la = -__expf(a.in[IN_S_ALOG][hd]) * dt;
        float cs = la;
#pragma unroll
        for (int o = 1; o < 64; o <<= 1) { const float t2 = __shfl_up(cs, o); if (c.lane >= o) cs += t2; }
        const float last = __shfl(cs, 63);
        dtv[c.wave * 64 + i] = dt; cumv[c.wave * 64 + i] = cs; edec[c.wave * 64 + i] = __expf(last - cs); ecum[c.wave * 64 + i] = __expf(cs);
        if (MODE == 1 && c.lane == 0) WSP(float, S_ELAST)[((size_t)b * 8 + hd) * 64 + ch] = __expf(last); }
    __syncthreads();
    const bf16* PROJ = WSP(bf16, A_PROJ); const float* cw = a.in[IN_CONV_SW]; const float* cb = a.in[IN_CONV_SB];
    bf16* XT = (bf16*)(lds + SS_XT); bf16* Bx = (bf16*)(lds + SS_B); bf16* Cx = (bf16*)(lds + SS_C);
    const int i = c.tid >> 3, g8 = c.tid & 7, t = ch * 64 + i;
#pragma unroll
    for (int sb = 0; sb < 4; ++sb) {
        if (MODE == 1 && sb == 3) continue;
        const int q0 = sb * 128 + g8 * 16;
        const int chx = (q0 < 256) ? grp * 256 + q0 : (q0 < 384 ? 512 + grp * 128 + (q0 - 256) : 768 + grp * 128 + (q0 - 384));
        float acc[16];
        { const float* bp = cb + chx; const f32x4 b0 = *(const GAS f32x4*)bp, b1 = *(const GAS f32x4*)(bp + 4), b2 = *(const GAS f32x4*)(bp + 8), b3 = *(const GAS f32x4*)(bp + 12);
          acc[0] = b0.x; acc[1] = b0.y; acc[2] = b0.z; acc[3] = b0.w; acc[4] = b1.x; acc[5] = b1.y; acc[6] = b1.z; acc[7] = b1.w;
          acc[8] = b2.x; acc[9] = b2.y; acc[10] = b2.z; acc[11] = b2.w; acc[12] = b3.x; acc[13] = b3.y; acc[14] = b3.z; acc[15] = b3.w; }
#pragma unroll
        for (int tap = 0; tap < 4; ++tap) { const int tt = t - 3 + tap; const float ok = (tt >= 0) ? 1.0f : 0.0f;
            { const bf16* src = PROJ + (size_t)(b * SEQ + (tt >= 0 ? tt : 0)) * PROJW + 2560 + chx; const v4u x0 = *(const GAS v4u*)src, x1 = *(const GAS v4u*)(src + 8);
                const float* wp = cw + tap * 1024 + chx; const f32x4 w0 = *(const GAS f32x4*)wp * ok, w1 = *(const GAS f32x4*)(wp + 4) * ok, w2 = *(const GAS f32x4*)(wp + 8) * ok, w3 = *(const GAS f32x4*)(wp + 12) * ok;
                acc[0] += w0.x * bflo(x0.x); acc[1] += w0.y * bfhi(x0.x); acc[2] += w0.z * bflo(x0.y); acc[3] += w0.w * bfhi(x0.y);
                acc[4] += w1.x * bflo(x0.z); acc[5] += w1.y * bfhi(x0.z); acc[6] += w1.z * bflo(x0.w); acc[7] += w1.w * bfhi(x0.w);
                acc[8] += w2.x * bflo(x1.x); acc[9] += w2.y * bfhi(x1.x); acc[10] += w2.z * bflo(x1.y); acc[11] += w2.w * bfhi(x1.y);
                acc[12] += w3.x * bflo(x1.z); acc[13] += w3.y * bfhi(x1.z); acc[14] += w3.z * bflo(x1.w); acc[15] += w3.w * bfhi(x1.w); } }
#pragma unroll
        for (int e = 0; e < 16; ++e) acc[e] = siluf(acc[e]);
        if (sb < 2) { const int hh = q0 >> 6; const float sc = (MODE == 1) ? dtv[hh * 64 + i] * edec[hh * 64 + i] : 1.0f;
#pragma unroll
            for (int e = 0; e < 16; ++e) XT[(q0 + e) * 72 + i] = (bf16)f2bf(acc[e] * sc); }
        else if (MODE == 1) {
#pragma unroll
            for (int e = 0; e < 16; ++e) Bx[(q0 - 256 + e) * 72 + i] = (bf16)f2bf(acc[e]); }
        else { bf16* dst = (sb == 2 ? Bx : Cx) + i * 136 + (q0 & 127);
            v4u o0, o1; o0.x = pk2(acc[0], acc[1]); o0.y = pk2(acc[2], acc[3]); o0.z = pk2(acc[4], acc[5]); o0.w = pk2(acc[6], acc[7]); o1.x = pk2(acc[8], acc[9]); o1.y = pk2(acc[10], acc[11]); o1.z = pk2(acc[12], acc[13]); o1.w = pk2(acc[14], acc[15]);
            *(v4u*)dst = o0; *(v4u*)(dst + 8) = o1; }
    }
    __syncthreads();
}
__device__ __forceinline__ void s1_item(const Args& a, const Ctx& c, unsigned char* lds, int item) {
    ssd_load<1>(a, c, lds, item);
    const int b = item >> 7, grp = (item >> 6) & 1, ch = item & 63;
    const bf16* XT = (const bf16*)(lds + SS_XT); const bf16* BT = (const bf16*)(lds + SS_B);
    const int hh = c.wave >> 1, pt = c.wave & 1, r32 = c.lane & 31, hi = c.lane >> 5;
    bf16* st = WSP(bf16, S_STATES) + (((size_t)b * 8 + grp * 4 + hh) * 64 + ch) * 8192;
    bf16x8 af[4];
#pragma unroll
    for (int ks = 0; ks < 4; ++ks) af[ks] = *(const bf16x8*)(XT + (hh * 64 + 32 * pt + r32) * 72 + 16 * ks + 8 * hi);
#pragma unroll
    for (int nt = 0; nt < 4; ++nt) { f32x16 acc;
#pragma unroll
        for (int r = 0; r < 16; ++r) acc[r] = 0.f;
#pragma unroll
        for (int ks = 0; ks < 4; ++ks) { const bf16x8 bv = *(const bf16x8*)(BT + (32 * nt + r32) * 72 + 16 * ks + 8 * hi); acc = MFMA32(af[ks], bv, acc); }
#pragma unroll
        for (int r = 0; r < 16; ++r) st[(32 * pt + crow(r, hi)) * 128 + 32 * nt + r32] = (bf16)f2bf(acc[r]); }
    __syncthreads();
}
__device__ __forceinline__ void s2_task(const Args& a, int task) {
    const int bh = task >> 11, e4 = (task & 2047) * 4;
    const bf16* st = WSP(bf16, S_STATES) + (size_t)bh * 64 * 8192 + e4; const float* el = WSP(float, S_ELAST) + (size_t)bh * 64; bf16* hc = WSP(bf16, S_HC) + (size_t)bh * 64 * 8192 + e4;
    f32x4 h = {0.f, 0.f, 0.f, 0.f};
    for (int c0 = 0; c0 < NCH; c0 += 16) {
        v2u sv[16]; float ev[16];
#pragma unroll
        for (int j = 0; j < 16; ++j) { sv[j] = *(const GAS v2u*)(st + (size_t)(c0 + j) * 8192); ev[j] = el[c0 + j]; }
#pragma unroll
        for (int j = 0; j < 16; ++j) { v2u o; o.x = pk2(h.x, h.y); o.y = pk2(h.z, h.w); *(GAS v2u*)(hc + (size_t)(c0 + j) * 8192) = o;
            const f32x4 sj = {bflo(sv[j].x), bfhi(sv[j].x), bflo(sv[j].y), bfhi(sv[j].y)}; h = h * ev[j] + sj; } }
    *(GAS f32x4*)(a.out + O_PSSM + (size_t)bh * 8192 + e4) = h;
}
constexpr int S3_CB = SS_END, S3_SC = S3_CB + 64 * 65 * 4  , S3_END = S3_SC + 4 * 64 * 72 * 2  ;
static_assert(S3_END <= RING_BYTES, "S3 LDS");
__device__ __forceinline__ void s3_item(const Args& a, const Ctx& c, unsigned char* lds, int item) {
    ssd_load<3>(a, c, lds, item);
    const int b = item >> 7, grp = (item >> 6) & 1, ch = item & 63, row0 = b * SEQ + ch * 64;
    const bf16* XT = (const bf16*)(lds + SS_XT); const bf16* Bm = (const bf16*)(lds + SS_B); const bf16* Cm = (const bf16*)(lds + SS_C);
    const float* dtv = (const float*)(lds + SS_DT); const float* cumv = (const float*)(lds + SS_CUM); const float* ecum = (const float*)(lds + SS_ECUM);
    float* CB = (float*)(lds + S3_CB); bf16* Sc = (bf16*)(lds + S3_SC);
    const int r32 = c.lane & 31, hi = c.lane >> 5;
    if (c.wave < 4) { const int ti = c.wave & 1, tj = c.wave >> 1; f32x16 acc;
#pragma unroll
        for (int r = 0; r < 16; ++r) acc[r] = 0.f;
        if (ti >= tj) {
#pragma unroll
            for (int kk = 0; kk < 8; ++kk) { const bf16x8 av = *(const bf16x8*)(Cm + (32 * ti + r32) * 136 + 16 * kk + 8 * hi), bv = *(const bf16x8*)(Bm + (32 * tj + r32) * 136 + 16 * kk + 8 * hi); acc = MFMA32(av, bv, acc); } }
#pragma unroll
        for (int r = 0; r < 16; ++r) CB[(32 * ti + crow(r, hi)) * 65 + 32 * tj + r32] = acc[r]; }
    __syncthreads();
#pragma unroll 4
    for (int k = 0; k < 32; ++k) { const int idx = c.tid + 512 * k, hh = idx >> 12, i = (idx >> 6) & 63, j = idx & 63;
        const float v = (i >= j) ? CB[i * 65 + j] * __expf(cumv[hh * 64 + i] - cumv[hh * 64 + j]) * dtv[hh * 64 + j] : 0.f;
        Sc[(hh * 64 + i) * 72 + j] = (bf16)f2bf(v); }
    __syncthreads();
    const int hh = c.wave >> 1, pt = c.wave & 1, hd = grp * 4 + hh;
    const bf16* hcp = WSP(bf16, S_HC) + (((size_t)b * 8 + hd) * 64 + ch) * 8192 + (size_t)(32 * pt + r32) * 128 + 8 * hi;
    f32x16 y[2];
#pragma unroll
    for (int it = 0; it < 2; ++it) { f32x16 a1, a2;
#pragma unroll
        for (int r = 0; r < 16; ++r) { a1[r] = 0.f; a2[r] = 0.f; }
#pragma unroll
        for (int ks = 0; ks < 4; ++ks) { const bf16x8 av = *(const bf16x8*)(Sc + (hh * 64 + 32 * it + r32) * 72 + 16 * ks + 8 * hi), bv = *(const bf16x8*)(XT + (hh * 64 + 32 * pt + r32) * 72 + 16 * ks + 8 * hi); a1 = MFMA32(av, bv, a1); }
#pragma unroll
        for (int kk = 0; kk < 8; ++kk) { const bf16x8 av = *(const bf16x8*)(Cm + (32 * it + r32) * 136 + 16 * kk + 8 * hi), bv = *(const GAS bf16x8*)(hcp + 16 * kk); a2 = MFMA32(av, bv, a2); }
#pragma unroll
        for (int r = 0; r < 16; ++r) y[it][r] = a1[r] + ecum[hh * 64 + 32 * it + crow(r, hi)] * a2[r]; }
    { const int chn = hh * 64 + 32 * pt + r32; const float Dh = a.in[IN_S_D][hd]; const bf16* PROJ = WSP(bf16, A_PROJ);
#pragma unroll
      for (int it = 0; it < 2; ++it)
#pragma unroll
          for (int r = 0; r < 16; ++r) { const int i = 32 * it + crow(r, hi); const float xs = bf2f(XT[chn * 72 + i]); y[it][r] = y[it][r] + Dh * xs; } }
    __syncthreads();
    float* Y = (float*)lds;
    { const int chn = hh * 64 + 32 * pt + r32;
#pragma unroll
      for (int it = 0; it < 2; ++it)
#pragma unroll
          for (int r = 0; r < 16; ++r) Y[(32 * it + crow(r, hi)) * 260 + chn] = y[it][r]; }
    __syncthreads();
    { const int i = c.tid >> 3, p8 = c.tid & 7; const float* yr = Y + i * 260 + p8 * 32; float v[32]; float ssq = 0.f;
#pragma unroll
      for (int q = 0; q < 8; ++q) { const f32x4 t4 = *(const f32x4*)(yr + 4 * q); v[4 * q] = t4.x; v[4 * q + 1] = t4.y; v[4 * q + 2] = t4.z; v[4 * q + 3] = t4.w; }
      { const bf16* zp = WSP(bf16, A_PROJ) + (size_t)(row0 + i) * PROJW + 2048 + grp * 256 + p8 * 32;
#pragma unroll
        for (int q = 0; q < 4; ++q) { const v4u zz = *(const GAS v4u*)(zp + 8 * q);
            v[8 * q] *= siluf(bflo(zz.x)); v[8 * q + 1] *= siluf(bfhi(zz.x)); v[8 * q + 2] *= siluf(bflo(zz.y)); v[8 * q + 3] *= siluf(bfhi(zz.y));
            v[8 * q + 4] *= siluf(bflo(zz.z)); v[8 * q + 5] *= siluf(bfhi(zz.z)); v[8 * q + 6] *= siluf(bflo(zz.w)); v[8 * q + 7] *= siluf(bfhi(zz.w)); } }
#pragma unroll
      for (int e = 0; e < 32; ++e) ssq += v[e] * v[e];
      ssq += __shfl_xor(ssq, 1); ssq += __shfl_xor(ssq, 2); ssq += __shfl_xor(ssq, 4);
      const float rstd = rsqrtf(ssq * (1.f / 256.f) + EPSN); const float* gn = a.in[IN_S_NORM] + grp * 256 + p8 * 32;
      bf16* dst = WSP(bf16, A_MIX) + (size_t)(row0 + i) * DM + 512 + grp * 256 + p8 * 32;
#pragma unroll
      for (int q = 0; q < 4; ++q) { v4u o; o.x = pk2(v[8 * q] * rstd * gn[8 * q], v[8 * q + 1] * rstd * gn[8 * q + 1]); o.y = pk2(v[8 * q + 2] * rstd * gn[8 * q + 2], v[8 * q + 3] * rstd * gn[8 * q + 3]);
          o.z = pk2(v[8 * q + 4] * rstd * gn[8 * q + 4], v[8 * q + 5] * rstd * gn[8 * q + 5]); o.w = pk2(v[8 * q + 6] * rstd * gn[8 * q + 6], v[8 * q + 7] * rstd * gn[8 * q + 7]); *(GAS v4u*)(dst + 8 * q) = o; } }
    __syncthreads();
}

__device__ __forceinline__ void gdn_dec_item(const Args& a, const Ctx& c, unsigned char* lds, int item) {
    const int b = item >> 2, h = item & 3, row = MP + b;
    float* qkv = (float*)lds;
    float* red = qkv + 384;
    float* kS = red + 16;
    float* qS = kS + 512;
    float* ov = qS + 512;
    const bf16* PROJ = WSP(bf16, A_PROJ); const float* GATES = WSP(float, A_GATES);
    const float* st_c = a.in[IN_SGC] + (size_t)b * 3 * 1536; const float* cw = a.in[IN_CONV_GW];
    const int rg = c.tid >> 7, col = c.tid & 127;
    const float* S0 = a.in[IN_SGDN] + ((size_t)b * 4 + h) * 16384;
    float s[32];
#pragma unroll
    for (int rr = 0; rr < 32; ++rr) s[rr] = S0[(rg * 32 + rr) * 128 + col];
    if (c.tid < 384) { const int X = c.tid >> 7, d = c.tid & 127, chn = X * 512 + h * 128 + d;
        const float xn = bf2f(PROJ[(size_t)row * PROJW + chn]);
        const float s0 = st_c[chn], s1 = st_c[1536 + chn], s2 = st_c[3072 + chn];
        float y = cw[chn] * s0 + cw[1536 + chn] * s1 + cw[3072 + chn] * s2 + cw[4608 + chn] * xn;
        y = siluf(y); qkv[c.tid] = y;
        float* oc = a.out + O_SGC + (size_t)b * 3 * 1536; oc[chn] = s1; oc[1536 + chn] = s2; oc[3072 + chn] = xn;
        const float ss = wave_sum(y * y); if (c.lane == 0) red[c.wave] = ss; }
    __syncthreads();
    const float rq = rsqrtf(red[0] + red[1] + EPSN) * 0.08838834764831845f, rk = rsqrtf(red[2] + red[3] + EPSN);
    const float ga = GATES[(size_t)row * 16 + h], gb = GATES[(size_t)row * 16 + 4 + h];
    const float g = -__expf(a.in[IN_G_ALOG][h]) * softplusf(ga + a.in[IN_G_DTB][h]), beta = sigmoidf(gb), eg = __expf(g);
    float pk_ = 0.f, pq_ = 0.f;
#pragma unroll
    for (int rr = 0; rr < 32; ++rr) { const int dk = rg * 32 + rr; pk_ += qkv[128 + dk] * rk * s[rr]; pq_ += qkv[dk] * rq * s[rr]; }
    kS[rg * 128 + col] = pk_; qS[rg * 128 + col] = pq_;
    if (c.wave < 2) { const float qk = wave_sum(qkv[c.tid] * rq * qkv[128 + c.tid] * rk); if (c.lane == 0) red[8 + c.wave] = qk; }
    __syncthreads();
    const float kSt = kS[col] + kS[128 + col] + kS[256 + col] + kS[384 + col], qSt = qS[col] + qS[128 + col] + qS[256 + col] + qS[384 + col];
    const float qk = red[8] + red[9];
    const float vnew = beta * (qkv[256 + col] - eg * kSt);
    const float o = eg * qSt + qk * vnew;
    float* So = a.out + O_SGDN + ((size_t)b * 4 + h) * 16384;
#pragma unroll
    for (int rr = 0; rr < 32; ++rr) { const int dk = rg * 32 + rr; So[dk * 128 + col] = s[rr] * eg + qkv[128 + dk] * rk * vnew; }
    if (rg == 0) { ov[col] = o; const float ss = wave_sum(o * o); if (c.lane == 0) red[12 + c.wave] = ss; }
    __syncthreads();
    if (rg == 0) { const float rstd = rsqrtf((red[12] + red[13]) * (1.f / 128.f) + EPSN);
        const float z = bf2f(PROJ[(size_t)row * PROJW + 1536 + h * 128 + col]);
        WSP(bf16, A_MIX)[(size_t)row * DM + h * 128 + col] = (bf16)f2bf(ov[col] * rstd * a.in[IN_G_NORM][col] * siluf(z)); }
    __syncthreads();
}
__device__ __forceinline__ void ssd_dec_item(const Args& a, const Ctx& c, unsigned char* lds, int item) {
    const int b = item >> 1, grp = item & 1, row = MP + b;
    float* xbc = (float*)lds;
    float* red = xbc + 512;
    float* yv = red + 16;
    const bf16* PROJ = WSP(bf16, A_PROJ); const float* GATES = WSP(float, A_GATES);
    const float* st_c = a.in[IN_SSC] + (size_t)b * 3 * 1024; const float* cw = a.in[IN_CONV_SW];
    const int hh = c.tid >> 7, hd = grp * 4 + hh, p = (c.tid & 127) >> 1, half = c.tid & 1;
    const float* h0 = a.in[IN_SSSM] + (((size_t)b * 8 + hd) * 64 + p) * 128 + half * 64; float* ho = a.out + O_SSSM + (((size_t)b * 8 + hd) * 64 + p) * 128 + half * 64;
    f32x4 hv[16];
#pragma unroll
    for (int q = 0; q < 16; ++q) hv[q] = *(const GAS f32x4*)(h0 + 4 * q);
    { const int q = c.tid; const int chx = (q < 256) ? grp * 256 + q : (q < 384 ? 512 + grp * 128 + (q - 256) : 768 + grp * 128 + (q - 384));
      const float xn = bf2f(PROJ[(size_t)row * PROJW + 2560 + chx]);
      const float s0 = st_c[chx], s1 = st_c[1024 + chx], s2 = st_c[2048 + chx];
      float y = cw[chx] * s0 + cw[1024 + chx] * s1 + cw[2048 + chx] * s2 + cw[3072 + chx] * xn + a.in[IN_CONV_SB][chx];
      xbc[q] = siluf(y);
      float* oc = a.out + O_SSC + (size_t)b * 3 * 1024; oc[chx] = s1; oc[1024 + chx] = s2; oc[2048 + chx] = xn; }
    __syncthreads();
    const float dt = softplusf(GATES[(size_t)row * 16 + 8 + hd] + a.in[IN_S_DTB][hd]); const float ela = __expf(-__expf(a.in[IN_S_ALOG][hd]) * dt);
    const float xs = xbc[hh * 64 + p], xdt = xs * dt;
    float yp = 0.f;
#pragma unroll
    for (int q = 0; q < 16; ++q) { const int n = half * 64 + 4 * q; f32x4 hn;
        hn.x = hv[q].x * ela + xdt * xbc[256 + n]; hn.y = hv[q].y * ela + xdt * xbc[256 + n + 1]; hn.z = hv[q].z * ela + xdt * xbc[256 + n + 2]; hn.w = hv[q].w * ela + xdt * xbc[256 + n + 3];
        yp += hn.x * xbc[384 + n] + hn.y * xbc[384 + n + 1] + hn.z * xbc[384 + n + 2] + hn.w * xbc[384 + n + 3];
        *(GAS f32x4*)(ho + 4 * q) = hn; }
    yp += __shfl_xor(yp, 1);
    const float z = bf2f(PROJ[(size_t)row * PROJW + 2048 + grp * 256 + hh * 64 + p]);
    const float yy = (yp + a.in[IN_S_D][hd] * xs) * siluf(z);
    const float ss = wave_sum(half == 0 ? yy * yy : 0.f); if (c.lane == 0) red[c.wave] = ss;
    if (half == 0) yv[hh * 64 + p] = yy;
    __syncthreads();
    if (c.tid < 256) { float tot = 0.f;
#pragma unroll
        for (int w = 0; w < 8; ++w) tot += red[w];
        const float rstd = rsqrtf(tot * (1.f / 256.f) + EPSN);
        WSP(bf16, A_MIX)[(size_t)row * DM + 512 + grp * 256 + c.tid] = (bf16)f2bf(yv[c.tid] * rstd * a.in[IN_S_NORM][grp * 256 + c.tid]); }
    __syncthreads();
}
__device__ __forceinline__ void prompt_conv_out(const Args& a, int idx) {
    const bf16* PROJ = WSP(bf16, A_PROJ);
    if (idx < 4 * 3 * 1536) { const int b = idx / 4608, r = (idx / 1536) % 3, chn = idx % 1536; a.out[O_PGC + idx] = bf2f(PROJ[(size_t)(b * SEQ + SEQ - 3 + r) * PROJW + chn]); }
    else { const int k = idx - 4 * 3 * 1536; const int b = k / 3072, r = (k / 1024) % 3, chn = k % 1024; a.out[O_PSC + k] = bf2f(PROJ[(size_t)(b * SEQ + SEQ - 3 + r) * PROJW + 2560 + chn]); }
}
__device__ __forceinline__ float rope_invfreq(int f) { return __builtin_amdgcn_exp2f(-(float)f * (13.287712379549449f / 16.0f)); }
struct C2In { f32x4 q0, q1, cv; float krv; };
__device__ __forceinline__ C2In c2_load(const Args& a, int m, int lane) { const float* src = WSP(float, C_CKV) + (size_t)m * DM; C2In r;
    r.q0 = *(const GAS f32x4*)(src + 4 * lane); r.q1 = *(const GAS f32x4*)(src + 256 + 4 * lane); r.cv = *(const GAS f32x4*)(src + 512 + 4 * lane); r.krv = src[768 + (lane & 31)]; return r; }
__device__ __forceinline__ void c2_row(const Args& a, int m, int lane, const C2In& in) {
    float* rows = (m < MP) ? a.out + O_PROWS + (size_t)m * ROWW : a.out + O_SROWS + (size_t)(m - MP) * ROWW;
    const float pos = (m < MP) ? (float)(m & (SEQ - 1)) : (float)PASTLEN;
    const f32x4 q0 = in.q0, q1 = in.q1, cv = in.cv;
    const float krv = (lane < 32) ? in.krv : 0.f;
    const float sq = wave_sum((q0.x * q0.x + q0.y * q0.y) + (q0.z * q0.z + q0.w * q0.w) + (q1.x * q1.x + q1.y * q1.y) + (q1.z * q1.z + q1.w * q1.w));
    const float sc = wave_sum((cv.x * cv.x + cv.y * cv.y) + (cv.z * cv.z + cv.w * cv.w));
    const float sk = wave_sum(krv * krv);
    const float rq = rsqrtf(sq * (1.f / 512.f) + EPSN), rc = rsqrtf(sc * (1.f / 256.f) + EPSN);
    { const f32x4 g0 = *(const GAS f32x4*)(a.in[IN_QA_NORM] + 4 * lane), g1 = *(const GAS f32x4*)(a.in[IN_QA_NORM] + 256 + 4 * lane);
      bf16* o = WSP(bf16, C_CQN) + (size_t)m * 512; v2u w0 = {pk2(q0.x * rq * g0.x, q0.y * rq * g0.y), pk2(q0.z * rq * g0.z, q0.w * rq * g0.w)}, w1 = {pk2(q1.x * rq * g1.x, q1.y * rq * g1.y), pk2(q1.z * rq * g1.z, q1.w * rq * g1.w)};
      *(GAS v2u*)(o + 4 * lane) = w0; *(GAS v2u*)(o + 256 + 4 * lane) = w1; }
    { const f32x4 g = *(const GAS f32x4*)(a.in[IN_KVA_NORM] + 4 * lane); const f32x4 y = cv * rc * g;
      *(GAS f32x4*)(rows + 4 * lane) = y; v2u w = {pk2(y.x, y.y), pk2(y.z, y.w)}; *(GAS v2u*)(WSP(bf16, C_CN) + (size_t)m * 256 + 4 * lane) = w; }
    { const int f = lane & 15; const float xk = (lane < 32) ? krv * a.in[IN_K_NORM][64 + lane] : 0.f; const float other = __shfl_xor(xk, 16);
      float sn, cs; sincosf(pos * rope_invfreq(f), &sn, &cs);
      const float out = (lane < 16) ? xk * cs - other * sn : xk * cs + other * sn;
      float* krx = WSP(float, C_KRX) + (size_t)m * 64;
      if (lane < 32) { rows[256 + lane] = out; krx[lane] = out; } if (lane == 32) krx[32] = sk; }
}
struct QIn { v4u x[3]; };
__device__ __forceinline__ QIn q_load(const bf16* qraw_row, int lane) { const int hq = lane >> 2, part = lane & 3; const bf16* s = qraw_row + hq * 96 + part * 24; QIn r;
#pragma unroll
    for (int q = 0; q < 3; ++q) r.x[q] = *(const GAS v4u*)(s + 8 * q);
    return r; }
__device__ __forceinline__ void q_head_to_lds(const Args& a, const QIn& qi, float pos, float* scr, int lane) {
    const int hq = lane >> 2, part = lane & 3; float v[24];
#pragma unroll
    for (int q = 0; q < 3; ++q) { const v4u x = qi.x[q]; v[8 * q] = bflo(x.x); v[8 * q + 1] = bfhi(x.x); v[8 * q + 2] = bflo(x.y); v[8 * q + 3] = bfhi(x.y); v[8 * q + 4] = bflo(x.z); v[8 * q + 5] = bfhi(x.z); v[8 * q + 6] = bflo(x.w); v[8 * q + 7] = bfhi(x.w); }
    float ssq = 0.f;
#pragma unroll
    for (int e = 0; e < 24; ++e) ssq += v[e] * v[e];
    ssq += __shfl_xor(ssq, 1); ssq += __shfl_xor(ssq, 2);
    const float rstd = rsqrtf(ssq * (1.f / 96.f) + EPSN); const float* qn = a.in[IN_Q_NORM] + part * 24;
#pragma unroll
    for (int e = 0; e < 24; ++e) scr[hq * 96 + part * 24 + e] = v[e] * rstd * qn[e];
    LDS_WAIT();
#pragma unroll
    for (int j = 0; j < 4; ++j) { const int pp = lane + 64 * j, hh = pp >> 4, f = pp & 15; float sn, cs; sincosf(pos * rope_invfreq(f), &sn, &cs);
        const float x1 = scr[hh * 96 + 64 + f], x2 = scr[hh * 96 + 80 + f]; LDS_WAIT();
        scr[hh * 96 + 64 + f] = x1 * cs - x2 * sn; scr[hh * 96 + 80 + f] = x2 * cs + x1 * sn; }
    LDS_WAIT();
}
struct C5In { QIn q; v4u k0, k1; f32x4 cv; float krv, ssc; };
__device__ __forceinline__ C5In c5_load(const Args& a, int m, int lane) { C5In r; r.q = q_load(WSP(bf16, C_QRAW) + (size_t)m * QP, lane);
    const int hq = lane >> 2, part = lane & 3; const bf16* s = WSP(bf16, C_KN) + (size_t)m * 1024 + hq * 64 + part * 16; r.k0 = *(const GAS v4u*)s; r.k1 = *(const GAS v4u*)(s + 8);
    const float* src = WSP(float, C_CKV) + (size_t)m * DM; r.cv = *(const GAS f32x4*)(src + 512 + 4 * lane); r.krv = src[768 + (lane & 31)];
    r.ssc = ((const float*)(a.ws + WS_CTL) + CW_SSQ + 4 * MT)[m]; return r; }
__device__ __forceinline__ void c5_row(const Args& a, int m, int lane, float* scr, const C5In& in) {
    const float pos = (m < MP) ? (float)(m & (SEQ - 1)) : (float)PASTLEN;
    float* rows = (m < MP) ? a.out + O_PROWS + (size_t)m * ROWW : a.out + O_SROWS + (size_t)(m - MP) * ROWW;
    { const float rc = rsqrtf(in.ssc * (1.f / 256.f) + EPSN); const f32x4 g = *(const GAS f32x4*)(a.in[IN_KVA_NORM] + 4 * lane); *(GAS f32x4*)(rows + 4 * lane) = in.cv * rc * g; }
    const float krv = (lane < 32) ? in.krv : 0.f; const float skr = wave_sum(krv * krv);
    { const int f = lane & 15; const float xk = (lane < 32) ? krv * a.in[IN_K_NORM][64 + lane] : 0.f; const float other = __shfl_xor(xk, 16);
      float sn, cs; sincosf(pos * rope_invfreq(f), &sn, &cs);
      const float out = (lane < 16) ? xk * cs - other * sn : xk * cs + other * sn;
      if (lane < 32) { rows[256 + lane] = out; scr[1536 + lane] = out; } }
    q_head_to_lds(a, in.q, pos, scr, lane);
    { const int hq = lane >> 2, part = lane & 3; const float* s = scr + hq * 96 + part * 24; bf16* o = WSP(bf16, C_QF) + (size_t)m * QP + hq * 96 + part * 24;
#pragma unroll
      for (int q = 0; q < 3; ++q) { v4u w; w.x = pk2(s[8 * q] * QSCALE, s[8 * q + 1] * QSCALE); w.y = pk2(s[8 * q + 2] * QSCALE, s[8 * q + 3] * QSCALE); w.z = pk2(s[8 * q + 4] * QSCALE, s[8 * q + 5] * QSCALE); w.w = pk2(s[8 * q + 6] * QSCALE, s[8 * q + 7] * QSCALE);
          *(GAS v4u*)(o + 8 * q) = w; } }
    LDS_WAIT();
    { const int hq = lane >> 2, part = lane & 3; const v4u x0 = in.k0, x1 = in.k1; float v[16];
      v[0] = bflo(x0.x); v[1] = bfhi(x0.x); v[2] = bflo(x0.y); v[3] = bfhi(x0.y); v[4] = bflo(x0.z); v[5] = bfhi(x0.z); v[6] = bflo(x0.w); v[7] = bfhi(x0.w);
      v[8] = bflo(x1.x); v[9] = bfhi(x1.x); v[10] = bflo(x1.y); v[11] = bfhi(x1.y); v[12] = bflo(x1.z); v[13] = bfhi(x1.z); v[14] = bflo(x1.w); v[15] = bfhi(x1.w);
      float ssq = 0.f;
#pragma unroll
      for (int e = 0; e < 16; ++e) ssq += v[e] * v[e];
      ssq += __shfl_xor(ssq, 1); ssq += __shfl_xor(ssq, 2);
      const float ir = rsqrtf((ssq + skr) * (1.f / 96.f) + EPSN);
      if (part == 0) rows[288 + hq] = ir;
      const float* kn = a.in[IN_K_NORM] + part * 16; bf16* o = WSP(bf16, C_KF) + (size_t)m * QP + hq * 96;
      v4u w0, w1; w0.x = pk2(v[0] * kn[0] * ir, v[1] * kn[1] * ir); w0.y = pk2(v[2] * kn[2] * ir, v[3] * kn[3] * ir); w0.z = pk2(v[4] * kn[4] * ir, v[5] * kn[5] * ir); w0.w = pk2(v[6] * kn[6] * ir, v[7] * kn[7] * ir);
      w1.x = pk2(v[8] * kn[8] * ir, v[9] * kn[9] * ir); w1.y = pk2(v[10] * kn[10] * ir, v[11] * kn[11] * ir); w1.z = pk2(v[12] * kn[12] * ir, v[13] * kn[13] * ir); w1.w = pk2(v[14] * kn[14] * ir, v[15] * kn[15] * ir);
      *(GAS v4u*)(o + part * 16) = w0; *(GAS v4u*)(o + part * 16 + 8) = w1;
      const f32x4 k0 = *(const f32x4*)(scr + 1536 + part * 8), k1 = *(const f32x4*)(scr + 1536 + part * 8 + 4);
      v4u w2; w2.x = pk2(k0.x * ir, k0.y * ir); w2.y = pk2(k0.z * ir, k0.w * ir); w2.z = pk2(k1.x * ir, k1.y * ir); w2.w = pk2(k1.z * ir, k1.w * ir);
      *(GAS v4u*)(o + 64 + part * 8) = w2; }
}
__device__ __forceinline__ void qcat_item(const Args& a, int item, int lane, float* scr) {
    const int b = item >> 4, h = item & 15, m = MP + b;
    q_head_to_lds(a, q_load(WSP(bf16, C_QRAW) + (size_t)m * QP, lane), (float)PASTLEN, scr, lane);
    const float* qh = scr + h * 96; bf16* o = WSP(bf16, D_QCAT) + ((size_t)b * 16 + h) * 288;
    const float* kn = a.in[IN_K_NORM]; const float* wuk = a.in[IN_W_UK];
#pragma unroll
    for (int j = 0; j < 4; ++j) { const int cc = lane + 64 * j; const float* wr = wuk + (size_t)cc * 1024 + h * 64; float acc = 0.f;
#pragma unroll
        for (int q = 0; q < 16; ++q) { const f32x4 w = *(const GAS f32x4*)(wr + 4 * q); acc += qh[4 * q] * kn[4 * q] * w.x + qh[4 * q + 1] * kn[4 * q + 1] * w.y + qh[4 * q + 2] * kn[4 * q + 2] * w.z + qh[4 * q + 3] * kn[4 * q + 3] * w.w; }
        o[cc] = (bf16)f2bf(acc * QSCALE); }
    if (lane < 32) o[256 + lane] = (bf16)f2bf(qh[64 + lane] * QSCALE);
    LDS_WAIT();
}

constexpr int AT_NSLOT = 4, AT_KB = 16384, AT_SLOT = AT_KB + 8192, AT_OST = AT_NSLOT * AT_SLOT, AT_END = AT_OST + 8 * 4096, AT_WS = RING_BYTES + 1024  ;
static_assert(AT_END <= RING_BYTES && AT_WS + 8 * 256 <= LDS_BYTES, "attention LDS");
__device__ __forceinline__ void glds16(const void* gsrc, unsigned lds_dst) { unsigned keep;
    asm volatile("s_mov_b32 %0, m0\n\ts_mov_b32 m0, %2\n\ts_nop 0\n\tglobal_load_lds_dwordx4 %1, off\n\ts_mov_b32 m0, %0" : "=&s"(keep) : "v"(gsrc), "s"(lds_dst) : "memory"); }
#define AT_WAIT_BAR(N) asm volatile("s_waitcnt vmcnt(" #N ") lgkmcnt(0)\n\ts_barrier" ::: "memory")
__device__ __forceinline__ void attn_unit(const Args& a, int b, int h, int qb, unsigned char* shm, int tid, bool pre, int nb, int nh) {
    const int lane = tid & 63, r32 = lane & 31, hi = lane >> 5; const int wid = __builtin_amdgcn_readfirstlane(tid >> 6);
    const size_t rowbase = (size_t)b * SEQ; const int q0 = qb * 256;
    const bf16* Qw = WSP(bf16, C_QF) + (rowbase + q0 + wid * 32) * QP + h * 96;
    const bf16* Kh = WSP(bf16, C_KF) + rowbase * QP + h * 96; const bf16* Vh = WSP(bf16, C_VV) + rowbase * 1024 + h * 64;
    const unsigned lds0 = (unsigned)(uintptr_t)shm;
    float* wsf = (float*)(shm + AT_WS) + wid * 64;
    const int krow = 4 * wid + (lane >> 4), kc = (lane & 15) ^ (krow & 15);
    const bf16* ksrc0 = Kh + (size_t)krow * QP + (kc < 12 ? kc : 0) * 8;
    const bf16* vsrc = Vh + (size_t)(16 * (wid & 3) + (lane >> 2)) * 1024 + (wid >> 2) * 32 + (lane & 3) * 8;
#define AT_DMA(t, slot) do { const unsigned sb_ = lds0 + (slot) * AT_SLOT; \
        glds16(ksrc0 + (size_t)(t) * 64 * QP, (unsigned)__builtin_amdgcn_readfirstlane(sb_ + wid * 1024)); \
        glds16(ksrc0 + (size_t)((t) * 64 + 32) * QP, (unsigned)__builtin_amdgcn_readfirstlane(sb_ + (wid + 8) * 1024)); \
        glds16(vsrc + (size_t)(t) * 64 * 1024, (unsigned)__builtin_amdgcn_readfirstlane(sb_ + AT_KB + wid * 1024)); } while (0)
    const int NT = 4 * qb + 4;
    bf16x8 qr[6];
#pragma unroll
    for (int d0 = 0; d0 < 6; ++d0) qr[d0] = *(const GAS bf16x8*)(Qw + (size_t)r32 * QP + d0 * 16 + hi * 8);
    asm volatile("" ::: "memory");
    if (!pre) { AT_DMA(0, 0); AT_DMA(1, 1); AT_DMA(2, 2); }
    float mrow = -INFINITY, lrow = 0.f; f32x16 o[2];
#pragma unroll
    for (int r = 0; r < 16; ++r) { o[0][r] = 0.f; o[1][r] = 0.f; }
    const int qrel = wid * 32 + r32;
    for (int t = 0; t < NT; ++t) {
        if (t + 2 < NT) AT_WAIT_BAR(6); else if (t + 1 < NT) AT_WAIT_BAR(3); else AT_WAIT_BAR(0);
        if (t + 3 < NT) AT_DMA(t + 3, (t + 3) & 3);
        else if (t == NT - 1 && nb >= 0) {
            const bf16* Kn = WSP(bf16, C_KF) + (size_t)nb * SEQ * QP + nh * 96; const bf16* Vn = WSP(bf16, C_VV) + (size_t)nb * SEQ * 1024 + nh * 64;
            const bf16* kn0 = Kn + (size_t)krow * QP + (kc < 12 ? kc : 0) * 8; const bf16* vn0 = Vn + (size_t)(16 * (wid & 3) + (lane >> 2)) * 1024 + (wid >> 2) * 32 + (lane & 3) * 8;
#pragma unroll
            for (int q = 0; q < 3; ++q) { const unsigned sb_ = lds0 + q * AT_SLOT;
                glds16(kn0 + (size_t)q * 64 * QP, (unsigned)__builtin_amdgcn_readfirstlane(sb_ + wid * 1024));
                glds16(kn0 + (size_t)(q * 64 + 32) * QP, (unsigned)__builtin_amdgcn_readfirstlane(sb_ + (wid + 8) * 1024));
                glds16(vn0 + (size_t)q * 64 * 1024, (unsigned)__builtin_amdgcn_readfirstlane(sb_ + AT_KB + wid * 1024)); } }
        const int jb = t - (NT - 4);
        if (jb >= 0 && 64 * jb > 32 * wid + 31) continue;
        typedef short v4i16_t __attribute__((ext_vector_type(4)));
        const LAS unsigned char* vp = (const LAS unsigned char*)shm + (t & 3) * AT_SLOT + AT_KB + ((lane >> 4) & 1) * 32 + (lane & 3) * 8 + (4 * hi + ((lane & 15) >> 2)) * 64;
        bf16x4 vlo[2][4], vhh[2][4];
#pragma unroll
        for (int d0 = 0; d0 < 2; ++d0)
#pragma unroll
            for (int ks = 0; ks < 4; ++ks) {
                vlo[d0][ks] = __builtin_bit_cast(bf16x4, __builtin_amdgcn_ds_read_tr16_b64_v4i16((LAS v4i16_t*)(vp + d0 * 4096 + ks * 1024)));
                vhh[d0][ks] = __builtin_bit_cast(bf16x4, __builtin_amdgcn_ds_read_tr16_b64_v4i16((LAS v4i16_t*)(vp + d0 * 4096 + ks * 1024 + 512))); }
        const unsigned char* Ks = shm + (t & 3) * AT_SLOT; const unsigned char* kb = Ks + r32 * 256; const int ksw = r32 & 15;
        f32x16 p0, p1;
#pragma unroll
        for (int r = 0; r < 16; ++r) { p0[r] = 0.f; p1[r] = 0.f; }
#pragma unroll
        for (int d0 = 0; d0 < 6; ++d0) { const int ko = ((2 * d0 + hi) ^ ksw) * 16; const bf16x8 b0 = *(const bf16x8*)(kb + ko), b1 = *(const bf16x8*)(kb + 8192 + ko); p0 = MFMA32(b0, qr[d0], p0); p1 = MFMA32(b1, qr[d0], p1); }
        if (jb >= 0) { const int kb0 = 64 * jb + 4 * hi;
#pragma unroll
            for (int r = 0; r < 16; ++r) { const int kv = kb0 + (r & 3) + 8 * (r >> 2); if (kv > qrel) p0[r] = -INFINITY; if (kv + 32 > qrel) p1[r] = -INFINITY; } }
        float rm = fmaxf(p0[0], p1[0]);
#pragma unroll
        for (int r = 1; r < 16; ++r) rm = fmaxf(rm, fmaxf(p0[r], p1[r]));
        { auto rr = __builtin_amdgcn_permlane32_swap(__float_as_uint(rm), __float_as_uint(rm), false, false); rm = fmaxf(__uint_as_float(rr[0]), __uint_as_float(rr[1])); }
        const float mn = fmaxf(mrow, rm); const float alpha = __builtin_amdgcn_exp2f(mrow - mn); mrow = mn;
        float rs = 0.f;
#pragma unroll
        for (int r = 0; r < 16; ++r) { p0[r] = __builtin_amdgcn_exp2f(p0[r] - mn); p1[r] = __builtin_amdgcn_exp2f(p1[r] - mn); rs += p0[r] + p1[r]; }
        lrow = lrow * alpha + rs;
        if (hi == 0) wsf[r32] = alpha;
        LDS_WAIT();
#pragma unroll
        for (int r = 0; r < 16; ++r) { const float al = wsf[crow(r, hi)]; o[0][r] *= al; o[1][r] *= al; }
        const bf16x8 pa0 = mk8(pk2(p0[0], p0[1]), pk2(p0[2], p0[3]), pk2(p0[4], p0[5]), pk2(p0[6], p0[7])), pa1 = mk8(pk2(p0[8], p0[9]), pk2(p0[10], p0[11]), pk2(p0[12], p0[13]), pk2(p0[14], p0[15]));
        const bf16x8 pa2 = mk8(pk2(p1[0], p1[1]), pk2(p1[2], p1[3]), pk2(p1[4], p1[5]), pk2(p1[6], p1[7])), pa3 = mk8(pk2(p1[8], p1[9]), pk2(p1[10], p1[11]), pk2(p1[12], p1[13]), pk2(p1[14], p1[15]));
        {
#define AT_PK(d, k) (bf16x8){vlo[d][k][0], vlo[d][k][1], vlo[d][k][2], vlo[d][k][3], vhh[d][k][0], vhh[d][k][1], vhh[d][k][2], vhh[d][k][3]}
            o[0] = MFMA32(pa0, AT_PK(0, 0), o[0]); o[1] = MFMA32(pa0, AT_PK(1, 0), o[1]); o[0] = MFMA32(pa1, AT_PK(0, 1), o[0]); o[1] = MFMA32(pa1, AT_PK(1, 1), o[1]);
            o[0] = MFMA32(pa2, AT_PK(0, 2), o[0]); o[1] = MFMA32(pa2, AT_PK(1, 2), o[1]); o[0] = MFMA32(pa3, AT_PK(0, 3), o[0]); o[1] = MFMA32(pa3, AT_PK(1, 3), o[1]);
#undef AT_PK
        }
    }
    { auto rr = __builtin_amdgcn_permlane32_swap(__float_as_uint(lrow), __float_as_uint(lrow), false, false); lrow = __uint_as_float(rr[0]) + __uint_as_float(rr[1]); }
    if (hi == 0) wsf[32 + r32] = lrow;
    LDS_WAIT();
    bf16* Ow = WSP(bf16, C_OA) + (rowbase + q0 + wid * 32) * 1024 + h * 64;
    { bf16* stg = (bf16*)(shm + AT_OST) + wid * 2048;
#pragma unroll
      for (int r = 0; r < 16; ++r) { const int orow = crow(r, hi); const float rl = __builtin_amdgcn_rcpf(wsf[32 + orow]);
#pragma unroll
          for (int d0 = 0; d0 < 2; ++d0) stg[orow * 64 + d0 * 32 + r32] = (bf16)f2bf(o[d0][r] * rl); }
      LDS_WAIT();
#pragma unroll
      for (int i = 0; i < 4; ++i) { const int row = i * 8 + (lane >> 3), ch8 = lane & 7; const v4u v = *(const v4u*)(stg + row * 64 + ch8 * 8); *(GAS v4u*)(Ow + (size_t)row * 1024 + ch8 * 8) = v; } }
    asm volatile("s_waitcnt lgkmcnt(0)\n\ts_barrier" ::: "memory");
#undef AT_DMA
}

constexpr int DA_L = 0, DA_IR = 128 * 296 * 2, DA_ML = DA_IR + 128 * 16 * 4, DA_CTX = DA_ML + 8 * 16 * 2 * 4, DA_QC = DA_CTX + 16 * 256 * 4, DA_END = DA_QC + 16 * 296 * 2;
static_assert(DA_END <= RING_BYTES, "decode attention LDS");
__device__ __forceinline__ void dec_attn_item(const Args& a, const Ctx& c, unsigned char* lds, int item) {
    const int b = item >> 3, split = item & 7; const int l15 = c.lane & 15, kq = c.lane >> 4, w = c.wave;
    bf16* L = (bf16*)(lds + DA_L); float* IR = (float*)(lds + DA_IR); float* MLs = (float*)(lds + DA_ML); float* CTX = (float*)(lds + DA_CTX);
    const int* pt = (const int*)a.in[IN_PT] + b * NPAGES + split * 8;
    bf16* QC = (bf16*)(lds + DA_QC);
    for (int i = c.tid; i < 16 * 36; i += NTHR) { const int hh = i / 36, q8 = i - hh * 36; *(v4u*)(QC + hh * 296 + 8 * q8) = *(const GAS v4u*)(WSP(bf16, D_QCAT) + ((size_t)b * 16 + hh) * 288 + 8 * q8); }
    f32x4 ctx[16];
#pragma unroll
    for (int ct = 0; ct < 16; ++ct) ctx[ct] = (f32x4){0.f, 0.f, 0.f, 0.f};
    float mh = -INFINITY, lh = 0.f;
    f32x4 v[19];
    { const f32x4* src = (const f32x4*)(a.in[IN_CACHE] + (size_t)pt[0] * (128 * ROWW));
#pragma unroll
      for (int k = 0; k < 19; ++k) v[k] = __builtin_nontemporal_load(src + c.tid + 512 * k); }
    for (int pg = 0; pg < 8; ++pg) {
        int tid_ = c.tid; asm volatile("" : "+v"(tid_));
        __syncthreads();
#pragma unroll
        for (int k = 0; k < 19; ++k) { const int idx = tid_ + 512 * k, row = idx / 76, c4 = idx - row * 76;
            if (c4 < 72) { v2u o = {pk2(v[k].x, v[k].y), pk2(v[k].z, v[k].w)}; *(v2u*)(L + row * 296 + 4 * c4) = o; }
            else *(f32x4*)(IR + row * 16 + 4 * (c4 - 72)) = v[k]; }
        __syncthreads();
        if (pg + 1 < 8) { const f32x4* src = (const f32x4*)(a.in[IN_CACHE] + (size_t)pt[pg + 1] * (128 * ROWW));
#pragma unroll
            for (int k = 0; k < 19; ++k) v[k] = __builtin_nontemporal_load(src + tid_ + 512 * k); }
        f32x4 acc = {0.f, 0.f, 0.f, 0.f};
        { const bf16* lr = L + (16 * w + l15) * 296 + 8 * kq;
#pragma unroll
          for (int ks = 0; ks < 9; ++ks) { const bf16x8 av = *(const bf16x8*)(lr + 32 * ks), qv = *(const bf16x8*)(QC + l15 * 296 + 8 * kq + 32 * ks); acc = MFMA16(av, qv, acc); } }
        float sc[4]; float ml = -INFINITY;
#pragma unroll
        for (int r = 0; r < 4; ++r) { sc[r] = acc[r] * IR[(16 * w + 4 * kq + r) * 16 + l15]; ml = fmaxf(ml, sc[r]); }
        ml = fmaxf(ml, __shfl_xor(ml, 16)); ml = fmaxf(ml, __shfl_xor(ml, 32));
        const float mn = fmaxf(mh, ml);
        if (__any(mn > mh)) { const float alpha = __builtin_amdgcn_exp2f(mh - mn); lh *= alpha;
            float al[4];
#pragma unroll
            for (int r = 0; r < 4; ++r) al[r] = __shfl(alpha, 4 * kq + r);
#pragma unroll
            for (int ct = 0; ct < 16; ++ct) { ctx[ct].x *= al[0]; ctx[ct].y *= al[1]; ctx[ct].z *= al[2]; ctx[ct].w *= al[3]; }
            mh = mn; }
        float p[4];
#pragma unroll
        for (int r = 0; r < 4; ++r) { p[r] = __builtin_amdgcn_exp2f(sc[r] - mh); lh += p[r]; }
        v2u pw = {pk2(p[0], p[1]), pk2(p[2], p[3])}; const bf16x4 pa = __builtin_bit_cast(bf16x4, pw);
        typedef short v4i16_t __attribute__((ext_vector_type(4)));
        const LAS unsigned char* ltp = (const LAS unsigned char*)lds + DA_L + ((16 * w + 4 * kq + (l15 >> 2)) * 296 + 4 * (l15 & 3)) * 2;
#pragma unroll
        for (int ct = 0; ct < 16; ++ct) { const bf16x4 bfr = __builtin_bit_cast(bf16x4, __builtin_amdgcn_ds_read_tr16_b64_v4i16((LAS v4i16_t*)(ltp + 32 * ct))); ctx[ct] = MFMA16K16(pa, bfr, ctx[ct]); }
    }
    lh += __shfl_xor(lh, 16); lh += __shfl_xor(lh, 32);
    __syncthreads();
    if (kq == 0) { MLs[(w * 16 + l15) * 2] = mh; MLs[(w * 16 + l15) * 2 + 1] = lh; }
    for (int i = c.tid; i < 4096; i += NTHR) CTX[i] = 0.f;
    __syncthreads();
    float fac[4]; float Mx[4];
#pragma unroll
    for (int r = 0; r < 4; ++r) { const int hh = 4 * kq + r; float M = -INFINITY;
#pragma unroll
        for (int ww = 0; ww < 8; ++ww) M = fmaxf(M, MLs[(ww * 16 + hh) * 2]);
        Mx[r] = M; fac[r] = __builtin_amdgcn_exp2f(__shfl(mh, hh) - M); }
    for (int ww = 0; ww < 8; ++ww) { if (w == ww) {
#pragma unroll
            for (int ct = 0; ct < 16; ++ct) { float* cp = CTX + (4 * kq) * 256 + 16 * ct + l15; cp[0] += ctx[ct].x * fac[0]; cp[256] += ctx[ct].y * fac[1]; cp[512] += ctx[ct].z * fac[2]; cp[768] += ctx[ct].w * fac[3]; } }
        __syncthreads(); }
    float* part = WSP(float, D_PART) + (size_t)item * 4096;
    for (int i = c.tid; i < 1024; i += NTHR) *(GAS f32x4*)(part + 4 * i) = *(const f32x4*)(CTX + 4 * i);
    if (c.tid < 16) { float M = -INFINITY;
#pragma unroll
        for (int ww = 0; ww < 8; ++ww) M = fmaxf(M, MLs[(ww * 16 + c.tid) * 2]);
        float Lsum = 0.f;
#pragma unroll
        for (int ww = 0; ww < 8; ++ww) Lsum += MLs[(ww * 16 + c.tid) * 2 + 1] * __builtin_amdgcn_exp2f(MLs[(ww * 16 + c.tid) * 2] - M);
        float* ml = WSP(float, D_ML) + (size_t)item * 32; ml[2 * c.tid] = M; ml[2 * c.tid + 1] = Lsum; }
    __syncthreads();
}
__device__ __forceinline__ void combine_item(const Args& a, int item, int lane, float* scr) {
    const int b = item >> 4, h = item & 15; const float* rows = a.out + O_SROWS + (size_t)b * ROWW;
    const bf16* qc = WSP(bf16, D_QCAT) + ((size_t)b * 16 + h) * 288;
    float cn[4]; float dot = 0.f;
#pragma unroll
    for (int j = 0; j < 4; ++j) { cn[j] = rows[lane + 64 * j]; dot += bf2f(qc[lane + 64 * j]) * cn[j]; }
    if (lane < 32) dot += bf2f(qc[256 + lane]) * rows[256 + lane];
    const float snew = wave_sum(dot) * rows[288 + h];
    float M = snew; float mj[8], lj[8];
#pragma unroll
    for (int j = 0; j < 8; ++j) { const float* ml = WSP(float, D_ML) + (size_t)(b * 8 + j) * 32 + 2 * h; mj[j] = ml[0]; lj[j] = ml[1]; M = fmaxf(M, mj[j]); }
    const float fn = __builtin_amdgcn_exp2f(snew - M); float Lsum = fn; float acc[4];
#pragma unroll
    for (int k = 0; k < 4; ++k) acc[k] = fn * cn[k];
#pragma unroll
    for (int j = 0; j < 8; ++j) { const float f = __builtin_amdgcn_exp2f(mj[j] - M); Lsum += lj[j] * f; const float* p = WSP(float, D_PART) + (size_t)(b * 8 + j) * 4096 + h * 256;
#pragma unroll
        for (int k = 0; k < 4; ++k) acc[k] += f * p[lane + 64 * k]; }
    const float inv = 1.0f / Lsum;
#pragma unroll
    for (int k = 0; k < 4; ++k) scr[lane + 64 * k] = acc[k] * inv;
    LDS_WAIT();
    const float* wv = a.in[IN_W_UV] + h * 64 + lane; float o = 0.f;
#pragma unroll 8
    for (int cc = 0; cc < 256; ++cc) o += scr[cc] * wv[(size_t)cc * 1024];
    WSP(bf16, C_OA)[(size_t)(MP + b) * 1024 + h * 64 + lane] = (bf16)f2bf(o);
    LDS_WAIT();
}
constexpr int NPH = 20;
#ifndef I14_QUEUE
#define I14_QUEUE 0
#endif
#ifndef ATTN_REP
#define ATTN_REP 1
#endif
#ifndef DEC_REP
#define DEC_REP 1
#endif
template <class Epi> __device__ __forceinline__ void run_gemm(unsigned char* lds, const bf16* A, const bf16* Bt, int N, int K, const Epi& E) {
    pg8::Gemm g{A, Bt, MP, N, K}; pg8::StaticOrder S; S.init(MP, N, (int)gridDim.x, (int)blockIdx.x);
    pg8::gemm_phase<Epi, pg8::StaticOrder, true, true>((PG8_LAS unsigned char*)lds, g, S, E);
}
__global__ void __launch_bounds__(NTHR, 2) hybrid_fwd(Args a) {
    extern __shared__ __attribute__((aligned(16))) unsigned char lds[];
    Ctx c; c.tid = threadIdx.x; c.lane = c.tid & 63; c.wave = __builtin_amdgcn_readfirstlane(c.tid >> 6); c.bid = blockIdx.x; c.G = gridDim.x; c.gw = c.bid * NWAVES + c.wave; c.NGW = c.G * NWAVES;
    for (int u = c.tid; u < (LDS_BYTES - LDSCTL_OFF) / 4; u += NTHR) ((LAS unsigned*)((LAS unsigned char*)lds + LDSCTL_OFF))[u] = 0u;
    __syncthreads();
#if MK_ONE_LAUNCH
    XcdBarrier bar = xcd_barrier_post((unsigned*)(a.ws + WS_CTL) + CW_BAR, (volatile LAS unsigned*)((LAS unsigned char*)lds + MISC_OFF) + 8);
#define GRID_BAR() xcd_barrier(bar)
#else
#define GRID_BAR() do {} while (0)
#endif
    const int lo = a.ph_lo, hi = a.ph_hi;
#ifndef PHMASK
#define PHMASK 0xFFFFFu
#endif
#define IN(k) ((((PHMASK) >> (k)) & 1u) && lo <= (k) && (k) < hi)
#define NEXTPH(k) (((k) == 5 || (k) == 8 || (k) == 10 || (k) == 16) ? (k) + 2 : (k) + 1)
#define SEAM(k) do { if (IN(k) && IN(NEXTPH(k))) GRID_BAR(); } while (0)
    float* wscr = (float*)(lds + c.wave * 8192);

    if (IN(0)) { ph_prologue(a, c, lds); } SEAM(0);
    if (IN(1)) { { SEpiBf16 e{WSP(bf16, A_PROJ) + (size_t)MP * PROJW, PROJW}; small_gemm(c, WSP(bf16, A_XN) + (size_t)MP * DM, DM, WSP(bf16, W_INA), 1024, PROJW / 16, e); }
        pg8::EpiBf16<0> E{WSP(bf16, A_PROJ), PROJW, nullptr, 0, 0, 1.f}; run_gemm(lds, WSP(bf16, A_XN), WSP(bf16, W_INA), PROJW, 1024, E);
        { const int nun = 64 * (PROJW / 256), rem = nun % c.G; const int first = rem ? rem : 0, nw = c.G - first;
          if (c.bid >= first) { __syncthreads(); ph_late_weights<0>(a, c, lds, (c.bid - first) * NWAVES + c.wave, nw * NWAVES); } } } SEAM(1);
    if (IN(2)) { for (int it = c.bid; it < 1024; it += c.G) g1_item(a, c, lds, it);
        for (int it = c.bid; it < 512; it += c.G) s1_item(a, c, lds, it); } SEAM(2);
    if (IN(3)) { const int nchainblk = (c.G > 16) ? 16 : 0;
        if (!(a.flags & 1)) for (int bh = c.bid; bh < 16; bh += c.G) { g2_block(a, c, lds, bh); __syncthreads(); }
        if (c.bid >= nchainblk && !(a.flags & 2)) { const int wb = c.bid - nchainblk, nwb = c.G - nchainblk;
            if (!(a.flags & 4)) for (int t = wb * NTHR + c.tid; t < 32 * 2048; t += nwb * NTHR) s2_task(a, t);
            for (int t = wb * NTHR + c.tid; t < 4 * 3 * 2560; t += nwb * NTHR) prompt_conv_out(a, t);
            if (!(a.flags & 8)) for (int it = wb; it < 512; it += nwb) gdn_dec_item(a, c, lds, it);
            if (!(a.flags & 16)) for (int it = wb; it < 256; it += nwb) ssd_dec_item(a, c, lds, it); } } SEAM(3);
    if (IN(4)) { for (int it = c.bid; it < 1024; it += c.G) g3_item(a, c, lds, it);
        for (int it = c.bid; it < 512; it += c.G) s3_item(a, c, lds, it); } SEAM(4);
    if (IN(5)) { float* ssq = (float*)(a.ws + WS_CTL) + CW_SSQ;
        { SEpiRes e{a.in[IN_XS], nullptr, DM, WSP(bf16, A_XN) + (size_t)MP * DM, ssq + MP, nullptr}; small_gemm(c, WSP(bf16, A_MIX) + (size_t)MP * DM, DM, WSP(bf16, W_OUTA), 1024, 64, e); }
        pg8::EpiResF32 E{a.in[IN_XP], nullptr, DM, WSP(bf16, A_XN), ssq, nullptr}; run_gemm(lds, WSP(bf16, A_MIX), WSP(bf16, W_OUTA), 1024, 1024, E); } SEAM(5);
    if (IN(7)) { const float* ssq = (const float*)(a.ws + WS_CTL) + CW_SSQ;
        { SEpiBf16 e{WSP(bf16, A_H) + (size_t)MP * DFF, DFF}; small_gemm_glu(c, WSP(bf16, A_XN) + (size_t)MP * DM, DM, WSP(bf16, W_GU0), 1024, ssq + MP, e); }
        pg8::EpiSwiGLU E{WSP(bf16, A_H), DFF, ssq}; run_gemm(lds, WSP(bf16, A_XN), WSP(bf16, W_GU0), 2 * DFF, 1024, E);
        { const int nun = 64 * (2 * DFF / 256), rem = nun % c.G; const int first = rem ? rem : 0, nw = c.G - first;
          if (c.bid >= first) { __syncthreads(); ph_late_weights<1>(a, c, lds, (c.bid - first) * NWAVES + c.wave, nw * NWAVES); } } } SEAM(7);
    if (IN(8)) { float* ssq = (float*)(a.ws + WS_CTL) + CW_SSQ + MT;
        { SEpiRes e{nullptr, WSP(bf16, A_XN) + (size_t)MP * DM, DM, WSP(bf16, A_XN) + (size_t)MP * DM, ssq + MP, nullptr}; small_gemm(c, WSP(bf16, A_H) + (size_t)MP * DFF, DFF, WSP(bf16, W_DN0), DFF, 64, e); }
        pg8::EpiResF32 E{nullptr, WSP(bf16, A_XN), DM, WSP(bf16, A_XN), ssq, nullptr}; run_gemm(lds, WSP(bf16, A_H), WSP(bf16, W_DN0), 1024, DFF, E); } SEAM(8);
    if (IN(10)) { float* sb = (float*)(a.ws + WS_CTL) + CW_SSQ; const float* ssx = sb + MT; float* ssq_q = sb + 3 * MT; float* ssq_c = sb + 4 * MT;
        { SEpiInC e{WSP(float, C_CKV) + (size_t)MP * DM, ssx + MP, WSP(bf16, C_CQN) + (size_t)MP * 512, WSP(bf16, C_CN) + (size_t)MP * 256, ssq_q + MP, ssq_c + MP}; small_gemm(c, WSP(bf16, A_XN) + (size_t)MP * DM, DM, WSP(bf16, W_INC), 1024, 64, e); }
        pg8::EpiInC E{WSP(float, C_CKV), DM, ssx, WSP(bf16, C_CQN), WSP(bf16, C_CN), ssq_q, ssq_c}; run_gemm(lds, WSP(bf16, A_XN), WSP(bf16, W_INC), 1024, 1024, E); } SEAM(10);
    if (IN(12)) { const float* sb = (const float*)(a.ws + WS_CTL) + CW_SSQ; const float* ssq_q = sb + 3 * MT; const float* ssq_c = sb + 4 * MT;
        { pg8::EpiBf16Rs E{WSP(bf16, C_QRAW), QP, ssq_q, 1.f / 512.f, 0, 0}; run_gemm(lds, WSP(bf16, C_CQN), WSP(bf16, W_UQ), QP, 512, E); }
        { const int rem = (64 * (QP / 256)) % c.G; Ctx c2 = c; if (rem) { c2.gw = (c.bid - rem) * NWAVES + c.wave; c2.NGW = (c.G - rem) * NWAVES; }
          if (c.bid >= rem) {
            { SEpiBf16Rs e{WSP(bf16, C_QRAW) + (size_t)MP * QP, QP, ssq_q + MP, 1.f / 512.f}; small_gemm(c2, WSP(bf16, C_CQN) + (size_t)MP * 512, 512, WSP(bf16, W_UQ), 512, QP / 16, e); }
            { SEpiBf16Rs e{WSP(bf16, C_KN) + (size_t)MP * 1024, 1024, ssq_c + MP, 1.f / 256.f}; small_gemm(c2, WSP(bf16, C_CN) + (size_t)MP * 256, 256, WSP(bf16, W_UKV), 256, 64, e); } } }
        { pg8::EpiBf16Rs E{WSP(bf16, C_KN), 1024, ssq_c, 1.f / 256.f, 1024, (size_t)(C_VV - C_KN) / 2}; run_gemm(lds, WSP(bf16, C_CN), WSP(bf16, W_UKV), 2048, 256, E); } } SEAM(12);
    if (IN(13)) { int m = c.gw; if (m < MT) { C5In cur = c5_load(a, m, c.lane);
            for (; m < MT; m += c.NGW) { const int mn = m + c.NGW; C5In nxt = cur; if (mn < MT) nxt = c5_load(a, mn, c.lane); c5_row(a, m, c.lane, wscr, cur); cur = nxt; } }
        for (int it = c.gw; it < MS * 16; it += c.NGW) qcat_item(a, it, c.lane, wscr); } SEAM(13);
#if I14_QUEUE
    if (IN(14)) {
        gu32* qa = (gu32*)(a.ws + WS_CTL) + CW_QATTN; gu32* qd = (gu32*)(a.ws + WS_CTL) + CW_QDEC;
        volatile int* qslot = (volatile int*)(lds + LDSCTL_OFF + 64);
        const bool dec_first = ((c.bid >> 3) % 5) < 2;
        bool attn_dry = false, dec_dry = false;
        for (;;) {
            if (c.tid == 0) { int kind = -1, idx = 0;
                for (int pass = 0; pass < 2 && kind < 0; ++pass) { const bool want_dec = (pass == 0) == dec_first;
                    if (want_dec) { if (!dec_dry) { idx = (int)__hip_atomic_fetch_add(qd, 1u, RLX_AGENT); if (idx < MS * 8) kind = 1; else dec_dry = true; } }
                    else { if (!attn_dry) { idx = (int)__hip_atomic_fetch_add(qa, 1u, RLX_AGENT); if (idx < 1024) kind = 0; else attn_dry = true; } } }
                qslot[0] = kind; qslot[1] = idx; }
            __syncthreads();
            const int kind = qslot[0], idx = qslot[1];
            __syncthreads();
            if (kind < 0) break;
            if (kind == 0) { const int qb = 15 - (idx >> 6), bh = idx & 63; attn_unit(a, bh >> 4, bh & 15, qb, lds, c.tid); }
            else dec_attn_item(a, c, lds, idx);
            __syncthreads();
        } } SEAM(14);
#else
    if (IN(14)) {
        for (int pass = 0; pass < 2; ++pass) { const bool do_attn = ((c.bid & 1) == 0) == (pass == 0);
            if (do_attn) { bool pre = false;
                for (int i = 0;; ++i) { const int idx = i * c.G + c.bid; if (idx >= 1024 || (a.flags & 32)) break; const int r = idx >> 8, vv = idx & 255, v = (vv & 7) * 32 + (vv >> 3)  , bh = v >> 2, s_ = v & 3;
                    const int qb = (r == 0) ? s_ : (r == 1) ? 7 - s_ : (r == 2) ? 8 + s_ : 15 - s_;
                    const int idn = idx + c.G; int nb = -1, nh = 0; if (idn < 1024) { const int vn = idn & 255, v2 = (vn & 7) * 32 + (vn >> 3), bh2 = v2 >> 2; nb = bh2 >> 4; nh = bh2 & 15; }
                    attn_unit(a, bh >> 4, bh & 15, qb, lds, c.tid, pre, nb, nh); pre = (nb >= 0); } }
            else { if (!(a.flags & 16) && !((a.flags & 64) && !(c.bid & 1))) for (int it = c.bid; it < MS * 8; it += c.G) dec_attn_item(a, c, lds, it); }
            __syncthreads(); } } SEAM(14);
#endif
    if (IN(15)) { for (int it = c.gw; it < MS * 16; it += c.NGW) combine_item(a, it, c.lane, wscr); } SEAM(15);
    if (IN(16)) { float* ssq = (float*)(a.ws + WS_CTL) + CW_SSQ + 2 * MT;
        { SEpiRes e{nullptr, WSP(bf16, A_XN) + (size_t)MP * DM, DM, WSP(bf16, A_XN) + (size_t)MP * DM, ssq + MP, nullptr}; small_gemm(c, WSP(bf16, C_OA) + (size_t)MP * 1024, 1024, WSP(bf16, W_OUTC), 1024, 64, e); }
        pg8::EpiResF32 E{nullptr, WSP(bf16, A_XN), DM, WSP(bf16, A_XN), ssq, nullptr}; run_gemm(lds, WSP(bf16, C_OA), WSP(bf16, W_OUTC), 1024, 1024, E); } SEAM(16);
    if (IN(18)) { const float* ssq = (const float*)(a.ws + WS_CTL) + CW_SSQ + 2 * MT;
        pg8::EpiSwiGLU E{WSP(bf16, A_H), DFF, ssq}; run_gemm(lds, WSP(bf16, A_XN), WSP(bf16, W_GU1), 2 * DFF, 1024, E);
        { const int rem = (64 * (2 * DFF / 256)) % c.G; Ctx c2 = c; if (rem) { c2.gw = (c.bid - rem) * NWAVES + c.wave; c2.NGW = (c.G - rem) * NWAVES; }
          if (c.bid >= rem) { SEpiBf16 e{WSP(bf16, A_H) + (size_t)MP * DFF, DFF}; small_gemm_glu(c2, WSP(bf16, A_XN) + (size_t)MP * DM, DM, WSP(bf16, W_GU1), 1024, ssq + MP, e); } } } SEAM(18);
    if (IN(19)) { { SEpiRes e{nullptr, WSP(bf16, A_XN) + (size_t)MP * DM, DM, nullptr, nullptr, a.out + O_YS}; small_gemm(c, WSP(bf16, A_H) + (size_t)MP * DFF, DFF, WSP(bf16, W_DN1), DFF, 64, e); }
        pg8::EpiResF32 E{nullptr, WSP(bf16, A_XN), DM, nullptr, nullptr, a.out + O_YP}; run_gemm(lds, WSP(bf16, A_H), WSP(bf16, W_DN1), 1024, DFF, E); }
#undef IN
#undef SEAM
}

extern "C" void kernel_launch(void* const* d_in, const int* in_sizes, int n_in, void* d_out, int out_size, void* d_ws, size_t ws_size, hipStream_t stream) {
    static int grid = 0;
    if (grid == 0) {
        if (n_in != 34 || out_size != (int)O_END || ws_size < WS_END) { fprintf(stderr, "kernel_launch: unexpected problem shape (n_in %d, out %d, ws %zu); nothing launched\n", n_in, out_size, ws_size); grid = -1; return; }
        int dev = 0, cus = 0, per_cu = 0;
        if (hipGetDevice(&dev) != hipSuccess || hipDeviceGetAttribute(&cus, hipDeviceAttributeMultiprocessorCount, dev) != hipSuccess) { grid = -1; return; }
        if (hipFuncSetAttribute((const void*)hybrid_fwd, hipFuncAttributeMaxDynamicSharedMemorySize, LDS_BYTES) != hipSuccess) { fprintf(stderr, "kernel_launch: hipFuncSetAttribute failed\n"); grid = -1; return; }
        if (hipOccupancyMaxActiveBlocksPerMultiprocessor(&per_cu, (const void*)hybrid_fwd, NTHR, LDS_BYTES) != hipSuccess || per_cu < 1) { fprintf(stderr, "kernel_launch: occupancy query says %d blocks per CU\n", per_cu); }
        (void)hipGetLastError();
        grid = cus;
    }
    if (grid < 0) return;
    if (hipMemsetAsync((char*)d_ws + WS_CTL, 0, CTL_ZERO_BYTES, stream) != hipSuccess) return;
    Args a{};
    for (int i = 0; i < 34; ++i) a.in[i] = (const float*)d_in[i];
    a.out = (float*)d_out; a.ws = (unsigned char*)d_ws;
#if MK_ONE_LAUNCH && !defined(PROBE_PHASE)
    a.ph_lo = 0; a.ph_hi = NPH;
    hipLaunchKernelGGL(hybrid_fwd, dim3(grid), dim3(NTHR), LDS_BYTES, stream, a);
#elif defined(PROBE_PHASE)
    for (int k = 0; k < NPH; ++k) { a.ph_lo = k; a.ph_hi = k + 1; a.flags = 0; hipLaunchKernelGGL(hybrid_fwd, dim3(grid), dim3(NTHR), LDS_BYTES, stream, a);
        if (k == PROBE_PHASE) { a.flags = PROBE_FLAGS; hipLaunchKernelGGL(hybrid_fwd, dim3(grid), dim3(NTHR), LDS_BYTES, stream, a); } }
#else
    for (int k = 0; k < NPH; ++k) { a.ph_lo = k; a.ph_hi = k + 1; hipLaunchKernelGGL(hybrid_fwd, dim3(grid), dim3(NTHR), LDS_BYTES, stream, a); }
#endif
}
```

```cpp
#include <hip/hip_runtime.h>
#include <cstdio>
#include <cstdint>
#include <cmath>
namespace pg8 {
#define PG8_LAS __attribute__((address_space(3)))
typedef unsigned short bf16_t;
typedef short bf16x8 __attribute__((ext_vector_type(8)));
typedef float f32x4 __attribute__((ext_vector_type(4)));
typedef unsigned u32x4 __attribute__((ext_vector_type(4)));
constexpr int BM = 256, BK = 64, HALF = 128, HTB = HALF * BK * 2  , STAGE_BYTES = 8 * HTB, NXCD = 8, WGM = 8;

__host__ __device__ __forceinline__ int lds_byte(int r, int c) { const int st = (r >> 4) * 2 + (c >> 5), rr = r & 15, cc = c & 31, ob = rr * 64 + cc * 2; return st * 1024 + (ob ^ (((ob >> 9) & 1) << 5)); }
__host__ __device__ __forceinline__ void stage_rc(int b, int& R, int& C) { const int st = b / 1024, sb = b % 1024, swz = sb ^ (((sb >> 9) & 1) << 5); R = (st >> 1) * 16 + swz / 64; C = (st & 1) * 32 + (swz % 64) / 2; }
__host__ __device__ __forceinline__ int perm32(int rho) { const int n = rho >> 4, i = rho & 15; return 8 * (i >> 2) + 4 * n + (i & 3); }

struct Unit { int pm, pn; };
struct Gemm { const bf16_t* A; const bf16_t* Bt; int M, N, K; };

struct StaticOrder {
    int nM, nN, nwg, G, c;
    __host__ __device__ void init(int M, int N, int G_, int c_) { nM = M / BM; nN = N / BM; nwg = nM * nN; G = G_; c = c_; }
    __host__ __device__ bool next(int i, Unit& u) const {
        const long L = (long)i * G + c; if (L >= nwg) return false;
        int wgid = (int)L; { const int q = nwg / NXCD, r = nwg % NXCD, xcd = wgid % NXCD, off = wgid / NXCD; wgid = (xcd < r ? xcd * (q + 1) : r * (q + 1) + (xcd - r) * q) + off; }
        const int nig = WGM * nN, gid = wgid / nig, fm = gid * WGM, gsz = (nM - fm) < WGM ? (nM - fm) : WGM;
        u.pm = fm + ((wgid % nig) % gsz); u.pn = (wgid % nig) / gsz; return true;
    }
    __device__ __forceinline__ void a_ready(const Unit&) const {}
    __device__ __forceinline__ void done(const Unit&) const {}
};

__device__ __forceinline__ unsigned cvt_pk_bf16(float lo, float hi) { unsigned r; asm volatile("v_cvt_pk_bf16_f32 %0, %1, %2" : "=v"(r) : "v"(lo), "v"(hi)); return r; }
typedef float f32x2 __attribute__((ext_vector_type(2)));
__device__ __forceinline__ f32x2 gelu_pk(f32x2 v) {
    const f32x2 av = __builtin_elementwise_abs(v), d = av * 0.2316418882f + 1.0f;
    f32x2 t; t.x = __builtin_amdgcn_rcpf(d.x); t.y = __builtin_amdgcn_rcpf(d.y);
    f32x2 q = t * 0.5307027145f + (-0.7265760135f); q = q * t + 0.7107068705f; q = q * t + (-0.142248368f); q = q * t + 0.127414796f; q = q * t;
    const f32x2 s = (v * v) * (-0.72134752044f);
    f32x2 e; e.x = __builtin_amdgcn_exp2f(s.x); e.y = __builtin_amdgcn_exp2f(s.y);
    const f32x2 m = v * (q * e), r = v - m;
    f32x2 o; o.x = v.x < 0.f ? m.x : r.x; o.y = v.y < 0.f ? m.y : r.y; return o;
}

template <int ACT  > struct EpiBf16 {
    static constexpr bool PERM = true, AFTER_DRAIN = false; static_assert(ACT == 0 || ACT == 1, "EpiBf16: ACT is 0 (none) or 1 (gelu_pk)");
    bf16_t* O; int ldc; const float* bias; int split_cols; size_t split_stride; float scale0;
    __device__ __forceinline__ void operator()(const f32x4 (&acc)[2][2][4][2], const Unit& u, int wr, int wc, int fr, int fq) const {
        const int row0 = u.pm * BM + wr * 64 + fr; int colt = u.pn * BM; bf16_t* base = O;
        float sc = 1.f; if (split_cols) { const int t = colt / split_cols; base += (size_t)t * split_stride; colt -= t * split_cols; if (t == 0) sc = scale0; }
        const int col0 = colt + wc * 32 + 8 * fq, bcol0 = u.pn * BM + wc * 32 + 8 * fq;
        f32x4 bv[2][2];
#pragma unroll
        for (int bj = 0; bj < 2; ++bj)
#pragma unroll
            for (int n = 0; n < 2; ++n) bv[bj][n] = bias ? *(const f32x4*)(bias + bcol0 + bj * HALF + 4 * n) : (f32x4){0.f, 0.f, 0.f, 0.f};
#pragma unroll
        for (int ai = 0; ai < 2; ++ai)
#pragma unroll
            for (int m = 0; m < 4; ++m) { bf16_t* rowp = base + (size_t)(row0 + ai * HALF + m * 16) * ldc + col0;
#pragma unroll
                for (int bj = 0; bj < 2; ++bj) { f32x4 v0 = acc[ai][bj][m][0] + bv[bj][0], v1 = acc[ai][bj][m][1] + bv[bj][1];
                    if (ACT == 1) { f32x2 a = gelu_pk((f32x2){v0[0], v0[1]}), b = gelu_pk((f32x2){v0[2], v0[3]}), c = gelu_pk((f32x2){v1[0], v1[1]}), d = gelu_pk((f32x2){v1[2], v1[3]});
                        v0 = (f32x4){a.x, a.y, b.x, b.y}; v1 = (f32x4){c.x, c.y, d.x, d.y}; }
                    v0 = v0 * sc; v1 = v1 * sc; u32x4 w; w.x = cvt_pk_bf16(v0[0], v0[1]); w.y = cvt_pk_bf16(v0[2], v0[3]); w.z = cvt_pk_bf16(v1[0], v1[1]); w.w = cvt_pk_bf16(v1[2], v1[3]);
                    *(u32x4*)(rowp + bj * HALF) = w; } }
    }
};
__device__ __forceinline__ float fast_silu(float g) { return g * __builtin_amdgcn_rcpf(1.0f + __builtin_amdgcn_exp2f(-1.4426950408889634f * g)); }
struct EpiF32 {
    static constexpr bool PERM = false, AFTER_DRAIN = false;
    float* C; int ldc; const float* ssq;
    __device__ __forceinline__ void operator()(const f32x4 (&acc)[2][2][4][2], const Unit& u, int wr, int wc, int fr, int fq) const {
        const int row0 = u.pm * BM + wr * 64 + fr, col0 = u.pn * BM + wc * 32 + 4 * fq;
#pragma unroll
        for (int ai = 0; ai < 2; ++ai)
#pragma unroll
            for (int m = 0; m < 4; ++m) { const int row = row0 + ai * HALF + m * 16; float* rowp = C + (size_t)row * ldc + col0; const float rs = __builtin_amdgcn_rsqf(ssq[row] * (1.f / 1024.f) + 1e-6f);
#pragma unroll
                for (int bj = 0; bj < 2; ++bj)
#pragma unroll
                    for (int n = 0; n < 2; ++n) *(f32x4*)(rowp + bj * HALF + n * 16) = acc[ai][bj][m][n] * rs; }
    }
};
struct EpiResF32 {
    static constexpr bool PERM = false, AFTER_DRAIN = false;
    const float* Rf; const bf16_t* Rb; int ldc; bf16_t* XN; float* ssq; float* Yf;
    __device__ __forceinline__ void operator()(const f32x4 (&acc)[2][2][4][2], const Unit& u, int wr, int wc, int fr, int fq) const {
        typedef unsigned u32x2v __attribute__((ext_vector_type(2)));
        const int row0 = u.pm * BM + wr * 64 + fr, col0 = u.pn * BM + wc * 32 + 4 * fq;
#pragma unroll
        for (int ai = 0; ai < 2; ++ai)
#pragma unroll
            for (int m = 0; m < 4; ++m) { const int row = row0 + ai * HALF + m * 16; const size_t off = (size_t)row * ldc + col0; float sq = 0.f;
#pragma unroll
                for (int bj = 0; bj < 2; ++bj)
#pragma unroll
                    for (int n = 0; n < 2; ++n) { const size_t o2 = off + bj * HALF + n * 16; f32x4 r;
                        if (Rf) r = *(const f32x4*)(Rf + o2);
                        else { const u32x2v rb = *(const u32x2v*)(Rb + o2); r[0] = __uint_as_float(rb.x << 16); r[1] = __uint_as_float(rb.x & 0xffff0000u); r[2] = __uint_as_float(rb.y << 16); r[3] = __uint_as_float(rb.y & 0xffff0000u); }
                        const f32x4 v = acc[ai][bj][m][n] + r;
                        if (Yf) *(f32x4*)(Yf + o2) = v;
                        if (XN) { u32x2v w; w.x = cvt_pk_bf16(v[0], v[1]); w.y = cvt_pk_bf16(v[2], v[3]); *(u32x2v*)(XN + o2) = w;
                            sq += (v[0] * v[0] + v[1] * v[1]) + (v[2] * v[2] + v[3] * v[3]); } }
                if (XN) { sq += __shfl_xor(sq, 16); sq += __shfl_xor(sq, 32); if (fq == 0) atomicAdd(ssq + row, sq); } }
    }
};
struct EpiSwiGLU {
    static constexpr bool PERM = true, AFTER_DRAIN = false;
    bf16_t* H; int ldh; const float* ssq;
    __device__ __forceinline__ void operator()(const f32x4 (&acc)[2][2][4][2], const Unit& u, int wr, int wc, int fr, int fq) const {
        const int row0 = u.pm * BM + wr * 64 + fr, col0 = u.pn * HALF + wc * 32 + 8 * fq;
#pragma unroll
        for (int ai = 0; ai < 2; ++ai)
#pragma unroll
            for (int m = 0; m < 4; ++m) { const int row = row0 + ai * HALF + m * 16; bf16_t* rowp = H + (size_t)row * ldh + col0; const float rs = __builtin_amdgcn_rsqf(ssq[row] * (1.f / 1024.f) + 1e-6f);
                const f32x4 g0 = acc[ai][0][m][0] * rs, g1 = acc[ai][0][m][1] * rs, u0 = acc[ai][1][m][0] * rs, u1 = acc[ai][1][m][1] * rs;
                u32x4 w; w.x = cvt_pk_bf16(fast_silu(g0[0]) * u0[0], fast_silu(g0[1]) * u0[1]); w.y = cvt_pk_bf16(fast_silu(g0[2]) * u0[2], fast_silu(g0[3]) * u0[3]);
                w.z = cvt_pk_bf16(fast_silu(g1[0]) * u1[0], fast_silu(g1[1]) * u1[1]); w.w = cvt_pk_bf16(fast_silu(g1[2]) * u1[2], fast_silu(g1[3]) * u1[3]);
                *(u32x4*)rowp = w; }
    }
};

struct EpiBf16Rs {
    static constexpr bool PERM = true, AFTER_DRAIN = false;
    bf16_t* O; int ldc; const float* ssq; float inv_n; int split_cols; size_t split_stride;
    __device__ __forceinline__ void operator()(const f32x4 (&acc)[2][2][4][2], const Unit& u, int wr, int wc, int fr, int fq) const {
        const int row0 = u.pm * BM + wr * 64 + fr; int colt = u.pn * BM; bf16_t* base = O;
        if (split_cols) { const int t = colt / split_cols; base += (size_t)t * split_stride; colt -= t * split_cols; }
        const int col0 = colt + wc * 32 + 8 * fq;
#pragma unroll
        for (int ai = 0; ai < 2; ++ai)
#pragma unroll
            for (int m = 0; m < 4; ++m) { const int row = row0 + ai * HALF + m * 16; bf16_t* rowp = base + (size_t)row * ldc + col0; const float rs = __builtin_amdgcn_rsqf(ssq[row] * inv_n + 1e-6f);
#pragma unroll
                for (int bj = 0; bj < 2; ++bj) { const f32x4 v0 = acc[ai][bj][m][0] * rs, v1 = acc[ai][bj][m][1] * rs;
                    u32x4 w; w.x = cvt_pk_bf16(v0[0], v0[1]); w.y = cvt_pk_bf16(v0[2], v0[3]); w.z = cvt_pk_bf16(v1[0], v1[1]); w.w = cvt_pk_bf16(v1[2], v1[3]);
                    *(u32x4*)(rowp + bj * HALF) = w; } }
    }
};
struct EpiInC {
    static constexpr bool PERM = false, AFTER_DRAIN = false;
    float* C; int ldc; const float* ssq_x; bf16_t* CQ; bf16_t* CK; float* ssq_q; float* ssq_c;
    __device__ __forceinline__ void operator()(const f32x4 (&acc)[2][2][4][2], const Unit& u, int wr, int wc, int fr, int fq) const {
        typedef unsigned u32x2v __attribute__((ext_vector_type(2)));
        const int row0 = u.pm * BM + wr * 64 + fr, colt = wc * 32 + 4 * fq;
#pragma unroll
        for (int ai = 0; ai < 2; ++ai)
#pragma unroll
            for (int m = 0; m < 4; ++m) { const int row = row0 + ai * HALF + m * 16; const float rs = __builtin_amdgcn_rsqf(ssq_x[row] * (1.f / 1024.f) + 1e-6f); float sq = 0.f;
#pragma unroll
                for (int bj = 0; bj < 2; ++bj)
#pragma unroll
                    for (int n = 0; n < 2; ++n) { const f32x4 v = acc[ai][bj][m][n] * rs; const int cc = colt + bj * HALF + n * 16;
                        if (u.pn == 2 || (u.pn == 3 && cc < 32)) *(f32x4*)(C + (size_t)row * ldc + u.pn * BM + cc) = v;
                        if (u.pn < 3) { u32x2v w; w.x = cvt_pk_bf16(v[0], v[1]); w.y = cvt_pk_bf16(v[2], v[3]);
                            if (u.pn < 2) *(u32x2v*)(CQ + (size_t)row * 512 + u.pn * BM + cc) = w; else *(u32x2v*)(CK + (size_t)row * 256 + cc) = w;
                            sq += (v[0] * v[0] + v[1] * v[1]) + (v[2] * v[2] + v[3] * v[3]); } }
                if (u.pn < 3) { sq += __shfl_xor(sq, 16); sq += __shfl_xor(sq, 32); if (fq == 0) atomicAdd((u.pn < 2 ? ssq_q : ssq_c) + row, sq); } }
    }
};
template <class Epi, class Sched, bool ALIGN_EPI = false, bool SP2 = false>
__device__ __forceinline__ void gemm_phase(PG8_LAS unsigned char* lds, const Gemm g, const Sched& S, const Epi& E) {
    const int tid = threadIdx.x, wid = __builtin_amdgcn_readfirstlane(tid >> 6), lane = tid & 63, wr = wid >> 2, wc = wid & 3, fr = lane & 15, fq = lane >> 4;
    const int K = g.K, nt = K / BK;
    unsigned voffA[2], voffB[2];
#pragma unroll
    for (int i = 0; i < 2; ++i) { int R, C; stage_rc(tid * 16 + i * 8192, R, C); const int Rb = Epi::PERM ? ((R & ~31) + perm32(R & 31)) : R;
        voffA[i] = (unsigned)(R * K + C) * 2u; voffB[i] = (unsigned)(Rb * K + C) * 2u; }
    const size_t kstep = (size_t)(BK * 2);
    const size_t hstep = (size_t)HALF * K * 2;
    const size_t tstep = 2 * hstep;
    const unsigned ldsw = (unsigned)wid * 1024u;
    const int aoff = lds_byte(wr * 64 + fr, fq * 8), boff = lds_byte(wc * 32 + fr, fq * 8);
#define PG8_SA(b, h) (((b) * 2 + (h)) * HTB)
#define PG8_SB(b, h) ((4 + (b) * 2 + (h)) * HTB)
#define PG8_STAGE(bufoff, gbase, voff) do { _Pragma("unroll") for (int _i = 0; _i < 2; ++_i) \
        __builtin_amdgcn_global_load_lds((const unsigned*)((const char*)(gbase) + (voff)[_i]), (PG8_LAS unsigned*)(lds + (bufoff) + ldsw + _i * 8192), 16, 0, 0); } while (0)
#define PG8_LDA(dst, b, h) do { _Pragma("unroll") for (int m = 0; m < 4; ++m) _Pragma("unroll") for (int k = 0; k < 2; ++k) dst[m][k] = *(const PG8_LAS bf16x8*)(lds + PG8_SA(b, h) + aoff + m * 2048 + k * 1024); } while (0)
#define PG8_LDB(dst, b, h) do { _Pragma("unroll") for (int n = 0; n < 2; ++n) _Pragma("unroll") for (int k = 0; k < 2; ++k) dst[n][k] = *(const PG8_LAS bf16x8*)(lds + PG8_SB(b, h) + boff + n * 2048 + k * 1024); } while (0)
#define PG8_MMA(ai, bj, At, Bt) do { __builtin_amdgcn_s_setprio(1); _Pragma("unroll") for (int m = 0; m < 4; ++m) _Pragma("unroll") for (int n = 0; n < 2; ++n) _Pragma("unroll") for (int k = 0; k < 2; ++k) \
        acc[ai][bj][m][n] = __builtin_amdgcn_mfma_f32_16x16x32_bf16(Bt[n][k], At[m][k], acc[ai][bj][m][n], 0, 0, 0); __builtin_amdgcn_s_setprio(0); } while (0)
#define PG8_WAIT_V(n) asm volatile("s_waitcnt vmcnt(" #n ")" ::: "memory")
#define PG8_WAIT_L(n) asm volatile("s_waitcnt lgkmcnt(" #n ")" ::: "memory")
#define PG8_BAR __builtin_amdgcn_s_barrier()
#define PG8_SCHED __builtin_amdgcn_sched_barrier(0)
    Unit cur, nxt; int ui = 0;
    if (!S.next(0, cur)) return;
    f32x4 acc[2][2][4][2];
#pragma unroll
    for (int a = 0; a < 2; ++a)
#pragma unroll
        for (int b = 0; b < 2; ++b)
#pragma unroll
            for (int m = 0; m < 4; ++m)
#pragma unroll
                for (int n = 0; n < 2; ++n) acc[a][b][m][n] = (f32x4){0.f, 0.f, 0.f, 0.f};
    bf16x8 At[4][2], B0[2][2], B1[2][2];
    const char* cA = (const char*)g.A + (size_t)cur.pm * tstep; const char* cB = (const char*)g.Bt + (size_t)cur.pn * tstep;
    S.a_ready(cur);
    if constexpr (SP2) {
        PG8_STAGE(PG8_SB(0, 0), cB, voffB); PG8_STAGE(PG8_SB(0, 1), cB + hstep, voffB); PG8_STAGE(PG8_SA(0, 0), cA, voffA); PG8_STAGE(PG8_SA(0, 1), cA + hstep, voffA);
        if (wr == 1) PG8_BAR;
        PG8_WAIT_V(2); PG8_BAR;
        PG8_STAGE(PG8_SB(1, 0), cB + kstep, voffB); PG8_STAGE(PG8_SA(1, 0), cA + kstep, voffA); PG8_STAGE(PG8_SB(1, 1), cB + hstep + kstep, voffB);
        PG8_WAIT_V(6); PG8_BAR;
    } else {
        PG8_STAGE(PG8_SB(0, 0), cB, voffB); PG8_STAGE(PG8_SA(0, 0), cA, voffA); PG8_STAGE(PG8_SB(0, 1), cB + hstep, voffB); PG8_STAGE(PG8_SA(0, 1), cA + hstep, voffA);
        if (wr == 1) PG8_BAR;
        PG8_WAIT_V(4); PG8_BAR;
        PG8_STAGE(PG8_SB(1, 0), cB + kstep, voffB); PG8_STAGE(PG8_SA(1, 0), cA + kstep, voffA); PG8_STAGE(PG8_SB(1, 1), cB + hstep + kstep, voffB);
        PG8_WAIT_V(6); PG8_BAR;
    }
    for (;;) {
        const bool has_next = S.next(ui + 1, nxt);
        const char* nA = has_next ? (const char*)g.A + (size_t)nxt.pm * tstep : cA; const char* nB = has_next ? (const char*)g.Bt + (size_t)nxt.pn * tstep : cB;
        for (int t = 0; t < nt; t += 2) {
            const bool last = (t == nt - 2);
            const char* a1 = cA + (size_t)(t + 1) * kstep;
            const char* a2 = last ? nA : cA + (size_t)(t + 2) * kstep; const char* b2 = last ? nB : cB + (size_t)(t + 2) * kstep;
            const char* a3 = a2 + kstep; const char* b3 = b2 + kstep;
            if (last && has_next) S.a_ready(nxt);
            if constexpr (SP2) {
            PG8_LDB(B0, 0, 0); PG8_LDB(B1, 0, 1); PG8_SCHED; PG8_LDA(At, 0, 0); PG8_STAGE(PG8_SA(1, 1), a1 + hstep, voffA);
            PG8_WAIT_V(8); PG8_WAIT_L(0); PG8_BAR; PG8_MMA(0, 0, At, B0); PG8_MMA(0, 1, At, B1); PG8_BAR; PG8_SCHED;
            PG8_LDA(At, 0, 1); PG8_STAGE(PG8_SB(0, 0), b2, voffB); PG8_STAGE(PG8_SB(0, 1), b2 + hstep, voffB); PG8_STAGE(PG8_SA(0, 0), a2, voffA);
            PG8_WAIT_V(8); PG8_WAIT_L(0); PG8_BAR; PG8_MMA(1, 0, At, B0); PG8_MMA(1, 1, At, B1); PG8_BAR; PG8_SCHED;
            PG8_LDB(B0, 1, 0); PG8_LDB(B1, 1, 1); PG8_SCHED; PG8_LDA(At, 1, 0); PG8_STAGE(PG8_SA(0, 1), a2 + hstep, voffA);
            PG8_WAIT_V(8); PG8_WAIT_L(0); PG8_BAR; PG8_MMA(0, 0, At, B0); PG8_MMA(0, 1, At, B1); PG8_BAR; PG8_SCHED;
            PG8_LDA(At, 1, 1); PG8_STAGE(PG8_SB(1, 0), b3, voffB); PG8_STAGE(PG8_SB(1, 1), b3 + hstep, voffB); PG8_STAGE(PG8_SA(1, 0), a3, voffA);
            PG8_WAIT_V(8); PG8_WAIT_L(0); PG8_BAR; PG8_MMA(1, 0, At, B0); PG8_MMA(1, 1, At, B1); PG8_BAR; PG8_SCHED;
            } else {
            PG8_LDB(B0, 0, 0); PG8_SCHED; PG8_LDA(At, 0, 0); PG8_STAGE(PG8_SA(1, 1), a1 + hstep, voffA);
            PG8_WAIT_L(8); PG8_BAR; PG8_WAIT_L(0); PG8_MMA(0, 0, At, B0); PG8_BAR; PG8_SCHED;
            PG8_LDB(B1, 0, 1); PG8_STAGE(PG8_SB(0, 0), b2, voffB);
            PG8_BAR; PG8_WAIT_L(0); PG8_MMA(0, 1, At, B1); PG8_BAR;
            PG8_LDA(At, 0, 1); PG8_STAGE(PG8_SA(0, 0), a2, voffA);
            PG8_BAR; PG8_WAIT_L(0); PG8_MMA(1, 0, At, B0); PG8_BAR; PG8_SCHED;
            PG8_STAGE(PG8_SB(0, 1), b2 + hstep, voffB);
            PG8_WAIT_V(6); PG8_BAR; PG8_MMA(1, 1, At, B1); PG8_BAR;
            PG8_LDB(B0, 1, 0); PG8_SCHED; PG8_LDA(At, 1, 0); PG8_STAGE(PG8_SA(0, 1), a2 + hstep, voffA);
            PG8_WAIT_L(8); PG8_BAR; PG8_WAIT_L(0); PG8_MMA(0, 0, At, B0); PG8_BAR; PG8_SCHED;
            PG8_LDB(B1, 1, 1); PG8_STAGE(PG8_SB(1, 0), b3, voffB);
            PG8_BAR; PG8_WAIT_L(0); PG8_MMA(0, 1, At, B1); PG8_BAR;
            PG8_LDA(At, 1, 1); PG8_STAGE(PG8_SA(1, 0), a3, voffA);
            PG8_BAR; PG8_WAIT_L(0); PG8_MMA(1, 0, At, B0); PG8_BAR; PG8_SCHED;
            PG8_STAGE(PG8_SB(1, 1), b3 + hstep, voffB);
            PG8_WAIT_V(6); PG8_BAR; PG8_MMA(1, 1, At, B1); PG8_BAR;
            }
        }
        if constexpr (ALIGN_EPI) { if (wr == 0) PG8_BAR; }
        if constexpr (!Epi::AFTER_DRAIN) { E(acc, cur, wr, wc, fr, fq); S.done(cur); }
        if (!has_next) break;
#pragma unroll
        for (int a = 0; a < 2; ++a)
#pragma unroll
            for (int b = 0; b < 2; ++b)
#pragma unroll
                for (int m = 0; m < 4; ++m)
#pragma unroll
                    for (int n = 0; n < 2; ++n) acc[a][b][m][n] = (f32x4){0.f, 0.f, 0.f, 0.f};
        cur = nxt; cA = nA; cB = nB; ++ui;
        if constexpr (ALIGN_EPI) { if (wr == 1) PG8_BAR; }
    }
    PG8_WAIT_V(0);
    if constexpr (!ALIGN_EPI) { if (wr == 0) PG8_BAR; }
    PG8_BAR;
    if constexpr (Epi::AFTER_DRAIN) { E.fused(acc, cur, wr, wc, fr, fq, lds, wid, lane); S.done(cur); }
#undef PG8_SA
#undef PG8_SB
#undef PG8_STAGE
#undef PG8_LDA
#undef PG8_LDB
#undef PG8_MMA
#undef PG8_WAIT_V
#undef PG8_WAIT_L
#undef PG8_BAR
#undef PG8_SCHED
}
}
#ifndef MK_ONE_LAUNCH
#define MK_ONE_LAUNCH 1
#endif
constexpr int NWAVES = 8, NTHR = 512;
constexpr int DM = 1024, BATCH = 4, SEQ = 4096, MP = BATCH * SEQ, MS = 128, MT = MP + MS, NCH = SEQ / 64;
constexpr int PROJW = 3584, IN_A = 3600, DFF = 2816, ROWW = 304, PASTLEN = 8192, NPAGES = 64;
constexpr int QP = 1536;
constexpr float EPSN = 1e-6f;
constexpr float QSCALE = 0.10206207261596577f * 1.4426950408889634f;
constexpr size_t MiB = 1u << 20;
constexpr size_t WS_CTL = 0, CTL_ZERO_BYTES = 1 * MiB;
constexpr size_t W_INA = 2 * MiB, W_OUTA = 10 * MiB, W_INC = 12 * MiB, W_UQ = 14 * MiB, W_UKV = 16 * MiB, W_OUTC = 18 * MiB, W_GU0 = 20 * MiB, W_GU1 = 32 * MiB, W_DN0 = 44 * MiB, W_DN1 = 50 * MiB;
constexpr size_t A_XN = 64 * MiB, A_GATES = 97 * MiB, A_PROJ = 100 * MiB, A_MIX = 214 * MiB, A_X1 = 248 * MiB, A_H = 314 * MiB, A_X2 = 404 * MiB, A_X3 = 470 * MiB;
constexpr size_t G_UIMG = 536 * MiB, G_WN = 568 * MiB, G_KDT = 584 * MiB, G_QE = 600 * MiB, G_AT = 616 * MiB, G_ELAST = 624 * MiB, G_SCT = 626 * MiB, G_VNT = 658 * MiB;
constexpr size_t S_STATES = 676 * MiB, S_ELAST = 740 * MiB, S_HC = 742 * MiB;
constexpr size_t C_CKV = 776 * MiB, C_CQN = 842 * MiB, C_CN = 860 * MiB, C_KRX = 870 * MiB, C_QRAW = 876 * MiB, C_KN = 926 * MiB, C_VV = 960 * MiB, C_QF = 994 * MiB, C_KF = 1044 * MiB, C_OA = 1094 * MiB;
constexpr size_t D_PART = 1128 * MiB, D_ML = 1144 * MiB, D_QCAT = 1146 * MiB, WS_END = 1150 * MiB;
constexpr size_t O_YP = 0, O_YS = O_YP + (size_t)MP * DM, O_PGDN = O_YS + (size_t)MS * DM, O_PGC = O_PGDN + 4 * 4 * 128 * 128, O_PSSM = O_PGC + 4 * 3 * 1536, O_PSC = O_PSSM + 4 * 8 * 64 * 128,
    O_PROWS = O_PSC + 4 * 3 * 1024, O_SGDN = O_PROWS + (size_t)MP * ROWW, O_SGC = O_SGDN + (size_t)MS * 4 * 128 * 128, O_SSSM = O_SGC + (size_t)MS * 3 * 1536, O_SSC = O_SSSM + (size_t)MS * 8 * 64 * 128,
    O_SROWS = O_SSC + (size_t)MS * 3 * 1024, O_END = O_SROWS + (size_t)MS * ROWW;
static_assert(O_END == 40243200, "output size");
constexpr int CW_BAR = 4096, CW_QATTN = 8192, CW_QDEC = 8256, CW_SSQ = 16384;
constexpr int RING_BYTES = 131072, LDSCTL_OFF = RING_BYTES, MISC_OFF = LDSCTL_OFF + 320, LDS_BYTES = 147456;

#define GAS __attribute__((address_space(1)))
#define LAS __attribute__((address_space(3)))
typedef unsigned short bf16;
typedef unsigned v4u __attribute__((ext_vector_type(4)));
typedef unsigned v2u __attribute__((ext_vector_type(2)));
typedef float f32x4 __attribute__((ext_vector_type(4)));
typedef float f32x16 __attribute__((ext_vector_type(16)));
typedef short bf16x8 __attribute__((ext_vector_type(8)));
typedef short bf16x4 __attribute__((ext_vector_type(4)));
typedef GAS unsigned gu32;
#define RLX_AGENT __ATOMIC_RELAXED, __HIP_MEMORY_SCOPE_AGENT
#define LDS_WAIT() asm volatile("s_waitcnt lgkmcnt(0)" ::: "memory")
#define VM_WAIT() asm volatile("s_waitcnt vmcnt(0)" ::: "memory")
#define MFMA32(a, b, c) __builtin_amdgcn_mfma_f32_32x32x16_bf16((a), (b), (c), 0, 0, 0)
#define MFMA16(a, b, c) __builtin_amdgcn_mfma_f32_16x16x32_bf16((a), (b), (c), 0, 0, 0)
#define MFMA16K16(a, b, c) __builtin_amdgcn_mfma_f32_16x16x16bf16_1k((a), (b), (c), 0, 0, 0)
__device__ __forceinline__ unsigned f2bf(float f) { unsigned u = __builtin_bit_cast(unsigned, f); return (u + 0x7fffu + ((u >> 16) & 1u)) >> 16; }
typedef float f32x2_t __attribute__((ext_vector_type(2))); typedef __bf16 bf16x2_t __attribute__((ext_vector_type(2)));
__device__ __forceinline__ unsigned pk2(float lo, float hi) { f32x2_t v = {lo, hi}; bf16x2_t b = __builtin_convertvector(v, bf16x2_t); return __builtin_bit_cast(unsigned, b); }
__device__ __forceinline__ float bf2f(bf16 b) { return __uint_as_float(((unsigned)b) << 16); }
__device__ __forceinline__ float bflo(unsigned u) { return __uint_as_float(u << 16); }
__device__ __forceinline__ float bfhi(unsigned u) { return __uint_as_float(u & 0xffff0000u); }
__device__ __forceinline__ int crow(int r, int hi) { return (r & 3) + 8 * (r >> 2) + 4 * hi; }
__device__ __forceinline__ float wave_sum(float v) {
#pragma unroll
    for (int o = 1; o < 64; o <<= 1) v += __shfl_xor(v, o);
    return v;
}
__device__ __forceinline__ float softplusf(float x) { return fmaxf(x, 0.f) + log1pf(__expf(-fabsf(x))); }
__device__ __forceinline__ float siluf(float x) { return x / (1.0f + __expf(-x)); }
__device__ __forceinline__ float sigmoidf(float x) { return 1.0f / (1.0f + __expf(-x)); }
__device__ __forceinline__ bf16x8 mk8(unsigned a, unsigned b, unsigned c, unsigned d) { v4u t = {a, b, c, d}; return __builtin_bit_cast(bf16x8, t); }
#define XB_TMO      128
#define XB_XCNT(j)  (256  + 64 * (j))
#define XB_XSUB(j)  (1280 + 64 * (j))
#define XB_XGEN(j)  (2304 + 64 * (j))
#define XB_TOP      3328
#define XB_TOPGEN   3392
#define XCD_BAR_WORDS 3456
#define XB_SPIN_CAP (1u << 18)

__device__ __forceinline__ unsigned xb_ld(unsigned* p)              { return __hip_atomic_load(p, __ATOMIC_RELAXED, __HIP_MEMORY_SCOPE_AGENT); }
__device__ __forceinline__ unsigned xb_add(unsigned* p, unsigned v) { return __hip_atomic_fetch_add(p, v, __ATOMIC_RELAXED, __HIP_MEMORY_SCOPE_AGENT); }
__device__ __forceinline__ unsigned xb_xcc_id() { return (unsigned)__builtin_amdgcn_s_getreg((3 << 11) | 20) & 0xFu; }
#define XB_SPIN(cond, bar) do { unsigned _sp = 0; while (cond) { __builtin_amdgcn_s_sleep(1); \
    if ((++_sp & 255u) == 0u) { if (xb_ld(&(bar)[XB_TMO])) break; if (_sp > XB_SPIN_CAP) { atomicAdd(&(bar)[XB_TMO], 1u); break; } } } } while (0)

struct XcdBarrier {
    unsigned* bar; unsigned x;
    volatile LAS unsigned* st;
};

__device__ __forceinline__ XcdBarrier xcd_barrier_post(unsigned* bar, volatile LAS unsigned* st) {
    XcdBarrier b; b.bar = bar; b.x = xb_xcc_id(); b.st = st;
    if (threadIdx.x == 0) (void)xb_add(&bar[XB_XCNT(b.x)], 1u);
    return b;
}
__device__ __forceinline__ void xcd_barrier_complete(unsigned* bar, unsigned x, unsigned& nloc, unsigned& nx) {
    const unsigned G = gridDim.x * gridDim.y * gridDim.z;
    unsigned sum, cnt, mine, sp = 0u;
    for (;;) {
        sum = 0u; cnt = 0u; mine = 0u;
#pragma unroll
        for (unsigned j = 0; j < 16; ++j) { const unsigned c = xb_ld(&bar[XB_XCNT(j)]); sum += c; cnt += (c > 0u) ? 1u : 0u; mine = (j == x) ? c : mine; }
        if (sum == G) break;
        __builtin_amdgcn_s_sleep(1);
        if ((++sp & 255u) == 0u) { if (xb_ld(&bar[XB_TMO])) break; if (sp > XB_SPIN_CAP) { atomicAdd(&bar[XB_TMO], 1u); break; } }
    }
    nloc = mine > 0u ? mine : 1u; nx = cnt > 0u ? cnt : 1u;
}

__device__ __forceinline__ void xcd_barrier(const XcdBarrier& b) {
    asm volatile("s_waitcnt vmcnt(0)" ::: "memory");
    __syncthreads();
    if (threadIdx.x == 0) {
        unsigned* bar = b.bar;
        __builtin_amdgcn_s_waitcnt(0);
        unsigned nloc = b.st[0], nx = b.st[1];
        if (nloc == 0u) { xcd_barrier_complete(bar, b.x, nloc, nx); b.st[0] = nloc; b.st[1] = nx; }
        const unsigned old = xb_add(&bar[XB_XSUB(b.x)], 1u);
        const unsigned gen = old / nloc;
        if (old + 1u == (gen + 1u) * nloc) {
            __builtin_amdgcn_fence(__ATOMIC_RELEASE, "agent");
            asm volatile("s_waitcnt vmcnt(0)" ::: "memory");
            const unsigned og = xb_add(&bar[XB_TOP], 1u);
            const unsigned tg = og / nx;
            if (og + 1u == (tg + 1u) * nx) xb_add(&bar[XB_TOPGEN], 1u);
            else XB_SPIN(xb_ld(&bar[XB_TOPGEN]) == tg, bar);
            __builtin_amdgcn_fence(__ATOMIC_ACQUIRE, "agent");
            xb_add(&bar[XB_XGEN(b.x)], 1u);
            asm volatile("s_waitcnt vmcnt(0)" ::: "memory");
        } else {
            XB_SPIN(xb_ld(&bar[XB_XGEN(b.x)]) == gen, bar);
            __builtin_amdgcn_fence(__ATOMIC_ACQUIRE, "agent");
            asm volatile("s_waitcnt vmcnt(0)" ::: "memory");
        }
    }
    __syncthreads();
}

__device__ __forceinline__ void sub_arrive(unsigned* w) {
    asm volatile("s_waitcnt vmcnt(0)" ::: "memory");
    __syncthreads();
    if (threadIdx.x == 0) { __builtin_amdgcn_s_waitcnt(0); __builtin_amdgcn_fence(__ATOMIC_RELEASE, "agent"); asm volatile("s_waitcnt vmcnt(0)" ::: "memory"); (void)xb_add(w, 1u); }
}
__device__ __forceinline__ void sub_wait(unsigned* w, unsigned n, unsigned* bar) {
    __syncthreads();
    if (threadIdx.x == 0) { XB_SPIN(xb_ld(w) < n, bar); __builtin_amdgcn_fence(__ATOMIC_ACQUIRE, "agent"); asm volatile("s_waitcnt vmcnt(0)" ::: "memory"); }
    __syncthreads();
}
struct Args { const float* in[34]; float* out; unsigned char* ws; int ph_lo, ph_hi, flags, pad; };
#define IN_XP 0
#define IN_XS 1
#define IN_SGDN 2
#define IN_SGC 3
#define IN_SSSM 4
#define IN_SSC 5
#define IN_CACHE 6
#define IN_PT 7
#define IN_NORM_A 8
#define IN_W_IN_A 9
#define IN_CONV_GW 10
#define IN_G_ALOG 11
#define IN_G_DTB 12
#define IN_G_NORM 13
#define IN_CONV_SW 14
#define IN_CONV_SB 15
#define IN_S_ALOG 16
#define IN_S_DTB 17
#define IN_S_D 18
#define IN_S_NORM 19
#define IN_W_OUT_A 20
#define IN_NORM_C 21
#define IN_W_IN_C 22
#define IN_QA_NORM 23
#define IN_KVA_NORM 24
#define IN_W_UQ 25
#define IN_W_UK 26
#define IN_W_UV 27
#define IN_Q_NORM 28
#define IN_K_NORM 29
#define IN_W_OUT_C 30
#define IN_NORM_F 31
#define IN_W_GU 32
#define IN_W_DN 33
#define WSP(T, off) ((T*)(a.ws + (off)))

struct Ctx { int tid, lane, wave, bid, G, gw, NGW; };

__device__ __forceinline__ void transpose_block(const float* W, int Nsrc, int K, bf16* WT, int kb, int dst_n0, int src_n0, LAS float* scr, int lane, const float* gain) {
    const int k0 = 64 * kb;
    float wv[32];
#pragma unroll
    for (int i = 0; i < 32; ++i) { const int kk = 2 * i + (lane >> 5); wv[i] = (src_n0 >= 0) ? W[(size_t)(k0 + kk) * Nsrc + src_n0 + (lane & 31)] : 0.f; }
#pragma unroll
    for (int i = 0; i < 32; ++i) { const int kk = 2 * i + (lane >> 5); const float gk = gain ? gain[k0 + kk] : 1.0f; scr[kk * 33 + (lane & 31)] = wv[i] * gk; }
    LDS_WAIT(); asm volatile("" ::: "memory");
    const int c = lane & 7;
#pragma unroll
    for (int j = 0; j < 4; ++j) { const int n = (lane >> 3) + 8 * j; const LAS float* s = scr + (8 * c) * 33 + n;
        v4u o; o.x = pk2(s[0 * 33], s[1 * 33]); o.y = pk2(s[2 * 33], s[3 * 33]); o.z = pk2(s[4 * 33], s[5 * 33]); o.w = pk2(s[6 * 33], s[7 * 33]);
        *(GAS v4u*)(WT + (size_t)(dst_n0 + n) * K + k0 + 8 * c) = o; }
    LDS_WAIT(); asm volatile("" ::: "memory");
}
__device__ __forceinline__ int map_col(int kind, int n) {
    if (kind == 1) return n < 2048 ? n : n + 8;
    if (kind == 2) return n < 800 ? n : -1;
    if (kind == 3) { const int pn = n >> 8, w = n & 255; return w < 128 ? 128 * pn + w : 2816 + 128 * pn + (w - 128); }
    return n;
}
__device__ __forceinline__ bool conv_matrix(int& r, const float* W, int Nsrc, int K, bf16* WT, int Ndst, int kind, LAS float* scr, int lane, const float* gain = nullptr) {
    const int nb32 = Ndst / 32, nblk = (K / 64) * nb32;
    if (r >= nblk) { r -= nblk; return false; }
    const int kb = r / nb32, nb = r % nb32;
    transpose_block(W, Nsrc, K, WT, kb, 32 * nb, map_col(kind, 32 * nb), scr, lane, gain);
    return true;
}
constexpr int blk_of(int K, int N) { return (K / 64) * (N / 32); }
constexpr int P0_NITEMS = blk_of(1024, 3584);
constexpr int LATE0_NITEMS = blk_of(1024, 1024) + blk_of(1024, 5632) + blk_of(2816, 1024);
constexpr int LATE1_NITEMS = blk_of(1024, 1024) * 2 + blk_of(512, 1536) + blk_of(256, 1024) * 2 + blk_of(1024, 5632) + blk_of(2816, 1024);

__device__ __forceinline__ void rms_row_regs(const f32x4 (&v)[4], const float* gain, bf16* orow, int lane, f32x4 (&y)[4]) {
    const GAS f32x4* gr = (const GAS f32x4*)gain + lane; float s = 0.f;
#pragma unroll
    for (int j = 0; j < 4; ++j) s += (v[j].x * v[j].x + v[j].y * v[j].y) + (v[j].z * v[j].z + v[j].w * v[j].w);
    const float rstd = rsqrtf(wave_sum(s) * (1.f / 1024.f) + EPSN);
    GAS v2u* o8 = (GAS v2u*)orow + lane;
#pragma unroll
    for (int j = 0; j < 4; ++j) { const f32x4 g = gr[64 * j]; y[j] = v[j] * rstd * g; v2u o; o.x = pk2(y[j].x, y[j].y); o.y = pk2(y[j].z, y[j].w); o8[64 * j] = o; }
}
__device__ __forceinline__ void rms_row(const float* xrow, const float* gain, bf16* orow, int lane, f32x4 (&y)[4]) {
    const GAS f32x4* xr = (const GAS f32x4*)xrow + lane; f32x4 v[4];
#pragma unroll
    for (int j = 0; j < 4; ++j) v[j] = xr[64 * j];
    rms_row_regs(v, gain, orow, lane, y);
}
__device__ __forceinline__ void ph_rmsnorm(const Args& a, const Ctx& c, const float* X, const float* gain) {
    bf16* XN = WSP(bf16, A_XN);
    for (int m = c.gw; m < MT; m += c.NGW) { f32x4 y[4]; rms_row(X + (size_t)m * DM, gain, XN + (size_t)m * DM, c.lane, y); }
}
__device__ __forceinline__ void ph_prologue(const Args& a, const Ctx& c, unsigned char* lds) {
    LAS float* scr = (LAS float*)((LAS unsigned char*)lds + c.wave * 16384);
    for (int it = c.gw; it < P0_NITEMS; it += c.NGW) { int r = it; conv_matrix(r, a.in[IN_W_IN_A], IN_A, 1024, WSP(bf16, W_INA), PROJW, 1, scr, c.lane); }
    __syncthreads();
    float* Wg = (float*)lds;
    for (int i = c.tid; i < 1024 * 4; i += NTHR) { const int k = i >> 2, q = i & 3; const int col = (q < 2) ? 2048 + 4 * q : 3592 + 4 * (q - 2);
        const f32x4 w = *(const f32x4*)(a.in[IN_W_IN_A] + (size_t)k * IN_A + col);
        Wg[(4 * q) * 1024 + k] = w.x; Wg[(4 * q + 1) * 1024 + k] = w.y; Wg[(4 * q + 2) * 1024 + k] = w.z; Wg[(4 * q + 3) * 1024 + k] = w.w; }
    __syncthreads();
    bf16* XN = WSP(bf16, A_XN); float* GATES = WSP(float, A_GATES);
    f32x4 xcur[4];
    if (c.gw < MT) { const int m0 = c.gw; const GAS f32x4* xr = (const GAS f32x4*)((m0 < MP) ? a.in[IN_XP] + (size_t)m0 * DM : a.in[IN_XS] + (size_t)(m0 - MP) * DM) + c.lane;
#pragma unroll
        for (int j = 0; j < 4; ++j) xcur[j] = xr[64 * j]; }
    for (int m = c.gw; m < MT; m += c.NGW) {
        f32x4 xnxt[4]; const int mn = m + c.NGW;
#pragma unroll
        for (int j = 0; j < 4; ++j) xnxt[j] = xcur[j];
        if (mn < MT) { const GAS f32x4* xr = (const GAS f32x4*)((mn < MP) ? a.in[IN_XP] + (size_t)mn * DM : a.in[IN_XS] + (size_t)(mn - MP) * DM) + c.lane;
#pragma unroll
            for (int j = 0; j < 4; ++j) xnxt[j] = xr[64 * j]; }
        f32x4 y[4]; rms_row_regs(xcur, a.in[IN_NORM_A], XN + (size_t)m * DM, c.lane, y);
#pragma unroll
        for (int j = 0; j < 4; ++j) xcur[j] = xnxt[j];
        float g[16];
#pragma unroll
        for (int q = 0; q < 16; ++q) g[q] = 0.f;
#pragma unroll
        for (int q = 0; q < 16; ++q) {
#pragma unroll
            for (int j = 0; j < 4; ++j) { const f32x4 w = *(const f32x4*)(Wg + q * 1024 + 4 * c.lane + 256 * j); g[q] += (y[j].x * w.x + y[j].y * w.y) + (y[j].z * w.z + y[j].w * w.w); }
            if ((q & 3) == 3) asm volatile("" ::: "memory"); }
#pragma unroll
        for (int q = 0; q < 16; ++q) g[q] = wave_sum(g[q]);
        float mine = 0.f;
#pragma unroll
        for (int q = 0; q < 16; ++q) mine = (c.lane == q) ? g[q] : mine;
        if (c.lane < 16) GATES[(size_t)m * 16 + c.lane] = mine;
    }
    __syncthreads();
}

template <int LAYER> __device__ __forceinline__ void ph_late_weights(const Args& a, const Ctx& c, unsigned char* lds, int wv, int nwv) {
    LAS float* scr = (LAS float*)((LAS unsigned char*)lds + c.wave * 16384);
    for (int it = wv; it < (LAYER == 0 ? LATE0_NITEMS : LATE1_NITEMS); it += nwv) {
        int r = it;
        if (LAYER == 0) {
            if (conv_matrix(r, a.in[IN_W_OUT_A], 1024, 1024, WSP(bf16, W_OUTA), 1024, 0, scr, c.lane)) continue;
            if (conv_matrix(r, a.in[IN_W_GU], 5632, 1024, WSP(bf16, W_GU0), 5632, 3, scr, c.lane, a.in[IN_NORM_F])) continue;
            conv_matrix(r, a.in[IN_W_DN], 1024, 2816, WSP(bf16, W_DN0), 1024, 0, scr, c.lane);
        } else {
            if (conv_matrix(r, a.in[IN_W_IN_C], 800, 1024, WSP(bf16, W_INC), 1024, 2, scr, c.lane, a.in[IN_NORM_C])) continue;
            if (conv_matrix(r, a.in[IN_W_UQ], 1536, 512, WSP(bf16, W_UQ), 1536, 0, scr, c.lane, a.in[IN_QA_NORM])) continue;
            if (conv_matrix(r, a.in[IN_W_UK], 1024, 256, WSP(bf16, W_UKV), 1024, 0, scr, c.lane, a.in[IN_KVA_NORM])) continue;
            if (conv_matrix(r, a.in[IN_W_UV], 1024, 256, WSP(bf16, W_UKV) + 1024 * 256, 1024, 0, scr, c.lane, a.in[IN_KVA_NORM])) continue;
            if (conv_matrix(r, a.in[IN_W_OUT_C], 1024, 1024, WSP(bf16, W_OUTC), 1024, 0, scr, c.lane)) continue;
            if (conv_matrix(r, a.in[IN_W_GU] + (size_t)1024 * 5632, 5632, 1024, WSP(bf16, W_GU1), 5632, 3, scr, c.lane, a.in[IN_NORM_F] + DM)) continue;
            conv_matrix(r, a.in[IN_W_DN] + (size_t)2816 * 1024, 1024, 2816, WSP(bf16, W_DN1), 1024, 0, scr, c.lane);
        }
    }
}

template <class F> __device__ __forceinline__ void small_gemm(const Ctx& c, const bf16* A, int lda, const bf16* Bt, int K, int nct, const F& epi) {
    const int l15 = c.lane & 15, kq = c.lane >> 4;
    for (int it = c.gw; it < 8 * nct; it += c.NGW) { const int rt = it & 7, ct = it >> 3;
        const bf16* ap = A + (size_t)(16 * rt + l15) * lda + 8 * kq; const bf16* bp = Bt + (size_t)(16 * ct + l15) * K + 8 * kq;
        f32x4 acc = {0.f, 0.f, 0.f, 0.f}, acc2 = {0.f, 0.f, 0.f, 0.f};
        for (int k0 = 0; k0 < K; k0 += 256) { bf16x8 av[8], bv[8];
#pragma unroll
            for (int j = 0; j < 8; ++j) { av[j] = *(const GAS bf16x8*)(ap + k0 + 32 * j); bv[j] = *(const GAS bf16x8*)(bp + k0 + 32 * j); }
#pragma unroll
            for (int j = 0; j < 8; j += 2) { acc = MFMA16(av[j], bv[j], acc); acc2 = MFMA16(av[j + 1], bv[j + 1], acc2); } }
        acc = acc + acc2;
#pragma unroll
        for (int r = 0; r < 4; ++r) epi(16 * rt + 4 * kq + r, 16 * ct + l15, acc[r]);
    }
}
template <class F> __device__ __forceinline__ void small_gemm_glu(const Ctx& c, const bf16* A, int lda, const bf16* Bt, int K, const float* ssq, const F& epi) {
    const int l15 = c.lane & 15, kq = c.lane >> 4;
    for (int it = c.gw; it < 8 * (DFF / 16); it += c.NGW) { const int rt = it & 7, ct = it >> 3; const int n = 16 * ct + l15; const int grow = 256 * (n >> 7) + (n & 127);
        const bf16* ap = A + (size_t)(16 * rt + l15) * lda + 8 * kq; const bf16* gp = Bt + (size_t)grow * K + 8 * kq; const bf16* up = gp + (size_t)128 * K;
        f32x4 ag = {0.f, 0.f, 0.f, 0.f}, au = {0.f, 0.f, 0.f, 0.f};
#pragma unroll 8
        for (int k = 0; k < K; k += 32) { const bf16x8 av = *(const GAS bf16x8*)(ap + k), gv = *(const GAS bf16x8*)(gp + k), uv = *(const GAS bf16x8*)(up + k); ag = MFMA16(av, gv, ag); au = MFMA16(av, uv, au); }
#pragma unroll
        for (int r = 0; r < 4; ++r) { const float rs = rsqrtf(ssq[16 * rt + 4 * kq + r] * (1.f / 1024.f) + EPSN); epi(16 * rt + 4 * kq + r, n, siluf(ag[r] * rs) * (au[r] * rs)); }
    }
}
struct SEpiBf16 { bf16* O; int ldo; __device__ __forceinline__ void operator()(int m, int n, float v) const { O[(size_t)m * ldo + n] = (bf16)f2bf(v); } };
struct SEpiF32 { float* O; int ldo; const float* ssq; __device__ __forceinline__ void operator()(int m, int n, float v) const { O[(size_t)m * ldo + n] = v * rsqrtf(ssq[m] * (1.f / 1024.f) + EPSN); } };
struct SEpiRes { const float* Rf; const bf16* Rb; int ldo; bf16* XN; float* ssq; float* Yf;
    __device__ __forceinline__ void operator()(int m, int n, float v) const { const size_t o = (size_t)m * ldo + n; const float x = (Rf ? Rf[o] : bf2f(Rb[o])) + v;
        if (Yf) Yf[o] = x;
        if (XN) { XN[o] = (bf16)f2bf(x); float sq = x * x; sq += __shfl_xor(sq, 1); sq += __shfl_xor(sq, 2); sq += __shfl_xor(sq, 4); sq += __shfl_xor(sq, 8); if ((n & 15) == 0) atomicAdd(ssq + m, sq); } } };
struct SEpiBf16Rs { bf16* O; int ldo; const float* ssq; float inv_n; __device__ __forceinline__ void operator()(int m, int n, float v) const { O[(size_t)m * ldo + n] = (bf16)f2bf(v * rsqrtf(ssq[m] * inv_n + EPSN)); } };
struct SEpiInC { float* C; const float* ssq_x; bf16* CQ; bf16* CK; float* ssq_q; float* ssq_c;
    __device__ __forceinline__ void operator()(int m, int n, float v) const { const float x = v * rsqrtf(ssq_x[m] * (1.f / 1024.f) + EPSN);
        if (n >= 512) C[(size_t)m * DM + n] = x;
        if (n < 768) { if (n < 512) CQ[(size_t)m * 512 + n] = (bf16)f2bf(x); else CK[(size_t)m * 256 + (n - 512)] = (bf16)f2bf(x); }
        float sq = (n < 768) ? x * x : 0.f; sq += __shfl_xor(sq, 1); sq += __shfl_xor(sq, 2); sq += __shfl_xor(sq, 4); sq += __shfl_xor(sq, 8);
        if ((n & 15) == 0 && n < 768) atomicAdd((n < 512 ? ssq_q : ssq_c) + m, sq); } };
__device__ __forceinline__ int invperm16(int k) { return 8 * ((k >> 2) & 1) + 4 * (k >> 3) + (k & 3); }
__device__ __forceinline__ void g1_item(const Args& a, const Ctx& c, unsigned char* lds, int item) {
    const int b = item >> 8, h = (item >> 6) & 3, ch = item & 63, row0 = b * SEQ + ch * 64;
    bf16* Qs = (bf16*)lds; bf16* Ks = (bf16*)(lds + 17408); bf16* Vs = (bf16*)(lds + 34816);
    float* Am = (float*)(lds + 52224); float* cumv = (float*)(lds + 68608); float* betav = cumv + 64; float* ecum = cumv + 128; float* edec = cumv + 192;
    const bf16* PROJ = WSP(bf16, A_PROJ); const float* GATES = WSP(float, A_GATES);
    const float* cw = a.in[IN_CONV_GW];
    float* cwl = (float*)(lds + 69632);
    for (int q = c.tid; q < 1536; q += NTHR) { const int tap = q / 384, r = q - tap * 384, X = r >> 7, d = r & 127; cwl[q] = cw[tap * 1536 + X * 512 + h * 128 + d]; }
    __syncthreads();
    { const int i = c.tid >> 3, g8 = c.tid & 7, t = ch * 64 + i;
#pragma unroll
      for (int X = 0; X < 3; ++X) {
        const int ch0 = X * 512 + h * 128 + g8 * 16;
        float acc[16];
#pragma unroll
        for (int e = 0; e < 16; ++e) acc[e] = 0.f;
        v4u xa[4], xb[4];
#pragma unroll
        for (int tap = 0; tap < 4; ++tap) { const int tt = t - 3 + tap; const bf16* src = PROJ + (size_t)(b * SEQ + (tt >= 0 ? tt : 0)) * PROJW + ch0; xa[tap] = *(const GAS v4u*)src; xb[tap] = *(const GAS v4u*)(src + 8); }
#pragma unroll
        for (int tap = 0; tap < 4; ++tap) { const int tt = t - 3 + tap; const float ok = (tt >= 0) ? 1.0f : 0.0f; const v4u x0 = xa[tap], x1 = xb[tap];
            { const float* wp = cwl + tap * 384 + X * 128 + g8 * 16; const f32x4 w0 = *(const f32x4*)wp * ok, w1 = *(const f32x4*)(wp + 4) * ok, w2 = *(const f32x4*)(wp + 8) * ok, w3 = *(const f32x4*)(wp + 12) * ok;
                acc[0] += w0.x * bflo(x0.x); acc[1] += w0.y * bfhi(x0.x); acc[2] += w0.z * bflo(x0.y); acc[3] += w0.w * bfhi(x0.y);
                acc[4] += w1.x * bflo(x0.z); acc[5] += w1.y * bfhi(x0.z); acc[6] += w1.z * bflo(x0.w); acc[7] += w1.w * bfhi(x0.w);
                acc[8] += w2.x * bflo(x1.x); acc[9] += w2.y * bfhi(x1.x); acc[10] += w2.z * bflo(x1.y); acc[11] += w2.w * bfhi(x1.y);
                acc[12] += w3.x * bflo(x1.z); acc[13] += w3.y * bfhi(x1.z); acc[14] += w3.z * bflo(x1.w); acc[15] += w3.w * bfhi(x1.w); } }
        float ssq = 0.f;
#pragma unroll
        for (int e = 0; e < 16; ++e) { acc[e] = siluf(acc[e]); ssq += acc[e] * acc[e]; }
        if (X < 2) { ssq += __shfl_xor(ssq, 1); ssq += __shfl_xor(ssq, 2); ssq += __shfl_xor(ssq, 4);
            const float rn = rsqrtf(ssq + EPSN) * (X == 0 ? 0.08838834764831845f : 1.0f);
#pragma unroll
            for (int e = 0; e < 16; ++e) acc[e] *= rn; }
        bf16* dst = (X == 0 ? Qs : (X == 1 ? Ks : Vs)) + i * 136 + g8 * 16;
        v4u o0, o1; o0.x = pk2(acc[0], acc[1]); o0.y = pk2(acc[2], acc[3]); o0.z = pk2(acc[4], acc[5]); o0.w = pk2(acc[6], acc[7]);
        o1.x = pk2(acc[8], acc[9]); o1.y = pk2(acc[10], acc[11]); o1.z = pk2(acc[12], acc[13]); o1.w = pk2(acc[14], acc[15]);
        *(v4u*)dst = o0; *(v4u*)(dst + 8) = o1;
      } }
    if (c.wave == 0) { const int i = c.lane; const float* gp = GATES + (size_t)(row0 + i) * 16;
        const float g = -__expf(a.in[IN_G_ALOG][h]) * softplusf(gp[h] + a.in[IN_G_DTB][h]); const float beta = sigmoidf(gp[4 + h]);
        float cs = g;
#pragma unroll
        for (int o = 1; o < 64; o <<= 1) { const float t2 = __shfl_up(cs, o); if (c.lane >= o) cs += t2; }
        const float last = __shfl(cs, 63);
        cumv[i] = cs; betav[i] = beta; ecum[i] = __expf(cs); edec[i] = __expf(last - cs);
        if (c.lane == 0) WSP(float, G_ELAST)[item] = __expf(last); }
    __syncthreads();
    { const int q = c.wave & 3, ti = q & 1, tj = q >> 1, r32 = c.lane & 31, hi = c.lane >> 5; const bool isKK = c.wave < 4;
      f32x16 acc;
#pragma unroll
      for (int r = 0; r < 16; ++r) acc[r] = 0.f;
      if (ti >= tj) { const bf16* Xa = (isKK ? Ks : Qs) + (32 * ti + r32) * 136 + 8 * hi; const bf16* Xb = Ks + (32 * tj + r32) * 136 + 8 * hi;
#pragma unroll
          for (int kk = 0; kk < 8; ++kk) { const bf16x8 av = *(const bf16x8*)(Xa + 16 * kk), bv = *(const bf16x8*)(Xb + 16 * kk); acc = MFMA32(av, bv, acc); } }
      const int j = 32 * tj + r32; const float cj = cumv[j]; bf16* AT = WSP(bf16, G_AT) + (size_t)item * 4096;
#pragma unroll
      for (int r = 0; r < 16; ++r) { const int i = 32 * ti + crow(r, hi);
          if (isKK) { const float e = (i > j) ? __expf(cumv[i] - cj) * betav[i] : 0.f; Am[i * 64 + j] = acc[r] * e; }
          else { const float e = (i >= j) ? __expf(cumv[i] - cj) : 0.f; AT[i * 64 + 16 * (j >> 4) + invperm16(j & 15)] = (bf16)f2bf(acc[r] * e); } } }
    { const int i = c.tid >> 3, g8 = c.tid & 7; const float e = ecum[i]; const bf16* s = Qs + i * 136 + g8 * 16; const v4u x0 = *(const v4u*)s, x1 = *(const v4u*)(s + 8);
      v4u o0, o1; o0.x = pk2(bflo(x0.x) * e, bfhi(x0.x) * e); o0.y = pk2(bflo(x0.y) * e, bfhi(x0.y) * e); o0.z = pk2(bflo(x0.z) * e, bfhi(x0.z) * e); o0.w = pk2(bflo(x0.w) * e, bfhi(x0.w) * e);
      o1.x = pk2(bflo(x1.x) * e, bfhi(x1.x) * e); o1.y = pk2(bflo(x1.y) * e, bfhi(x1.y) * e); o1.z = pk2(bflo(x1.z) * e, bfhi(x1.z) * e); o1.w = pk2(bflo(x1.w) * e, bfhi(x1.w) * e);
      bf16* dst = WSP(bf16, G_QE) + (size_t)item * 8192 + i * 128 + g8 * 16;
      const v4u q0 = {o0.x, o0.y, o1.x, o1.y}, q1 = {o0.z, o0.w, o1.z, o1.w};
      *(GAS v4u*)dst = q0; *(GAS v4u*)(dst + 8) = q1; }
#pragma unroll
    for (int rep = 0; rep < 2; ++rep) { const int idx = c.tid + 512 * rep, d = idx >> 3, ig = idx & 7; float v[8];
#pragma unroll
        for (int jj = 0; jj < 8; ++jj) { const int i = 16 * (ig >> 1) + 8 * (jj >> 2) + 4 * (ig & 1) + (jj & 3); v[jj] = bf2f(Ks[i * 136 + d]) * edec[i]; }
        v4u o; o.x = pk2(v[0], v[1]); o.y = pk2(v[2], v[3]); o.z = pk2(v[4], v[5]); o.w = pk2(v[6], v[7]);
        *(GAS v4u*)(WSP(bf16, G_KDT) + (size_t)item * 8192 + d * 64 + 8 * ig) = o; }
    __syncthreads();
    float x[64];
#pragma unroll
    for (int i = 0; i < 64; ++i) x[i] = 0.f;
    if (c.tid < 256) { const bool isU = c.tid < 128; const int d = c.tid & 127; const bf16* Xs_ = isU ? Vs : Ks;
#pragma unroll
        for (int i = 0; i < 64; ++i) { float rhs = bf2f(Xs_[i * 136 + d]) * betav[i]; if (!isU) rhs *= ecum[i];
            const float* Ar = Am + i * 64;
            float s1 = 0.f, s2 = 0.f, s3 = 0.f;
#pragma unroll
            for (int j4 = 0; j4 < i; j4 += 4) { const f32x4 av = *(const f32x4*)(Ar + j4);
                rhs -= av.x * x[j4]; if (j4 + 1 < i) s1 -= av.y * x[j4 + 1]; if (j4 + 2 < i) s2 -= av.z * x[j4 + 2]; if (j4 + 3 < i) s3 -= av.w * x[j4 + 3]; }
            rhs = (rhs + s1) + (s2 + s3);
            asm volatile("" : "+v"(rhs) :: "memory"); x[i] = rhs; } }
    __syncthreads();
    bf16* Uimg = (bf16*)lds; bf16* Wimg = (bf16*)(lds + 32768);
    if (c.tid < 128) { const int d = c.tid, slice = d >> 5, col = d & 31;
#pragma unroll
        for (int i = 0; i < 64; ++i) { const int rt = i >> 5, ri = i & 31, hi_ = (ri >> 2) & 1, r = (ri & 3) + 4 * (ri >> 3); Uimg[((slice * 2 + rt) * 64 + col + 32 * hi_) * 16 + r] = (bf16)f2bf(x[i]); } }
    else if (c.tid < 256) { const int d = c.tid - 128, pos = 16 * (d >> 4) + invperm16(d & 15);
#pragma unroll
        for (int i = 0; i < 64; ++i) Wimg[i * 128 + pos] = (bf16)f2bf(-x[i]); }
    __syncthreads();
    { bf16* Ug = WSP(bf16, G_UIMG) + (size_t)item * 8192; bf16* Wg = WSP(bf16, G_WN) + (size_t)item * 8192;
#pragma unroll
      for (int k = 0; k < 2; ++k) { const int q = c.tid + 512 * k; *(GAS v4u*)(Ug + 8 * q) = *(const v4u*)(Uimg + 8 * q); *(GAS v4u*)(Wg + 8 * q) = *(const v4u*)(Wimg + 8 * q); } }
    __syncthreads();
}

constexpr int G2_SLOT = 35840, G2_KD = 17408;
__device__ __forceinline__ void g2_block(const Args& a, const Ctx& c, unsigned char* lds, int bh) {
    const bf16* Ug = WSP(bf16, G_UIMG); const bf16* Wn = WSP(bf16, G_WN); const bf16* Kd = WSP(bf16, G_KDT); const float* El = WSP(float, G_ELAST);
    bf16* SCt = WSP(bf16, G_SCT); bf16* VNt = WSP(bf16, G_VNT);
    const int lane = c.lane, r32 = lane & 31, hi = lane >> 5;
#define G2_BAR() do { LDS_WAIT(); __builtin_amdgcn_s_barrier(); asm volatile("" ::: "memory"); } while (0)
    if (c.wave >= 4) {
        const int hl = (c.wave - 4) * 64 + lane;
        int wo[4], ko[4];
#pragma unroll
        for (int k = 0; k < 4; ++k) { const int p = hl + 256 * k; wo[k] = (p >> 4) * 272 + (p & 15) * 16; ko[k] = G2_KD + (p >> 3) * 144 + (p & 7) * 16; }
        v4u r0w[4], r0k[4], r1w[4], r1k[4], r2w[4], r2k[4], r3w[4], r3k[4];
#define G2_LOAD(RW, RK, ch) do { const size_t it_ = ((size_t)bh * 64 + (ch)) * 8192; _Pragma("unroll") for (int k = 0; k < 4; ++k) { RW[k] = *(const GAS v4u*)(Wn + it_ + (size_t)(hl + 256 * k) * 8); RK[k] = *(const GAS v4u*)(Kd + it_ + (size_t)(hl + 256 * k) * 8); } } while (0)
#define G2_PUT(RW, RK, slot) do { unsigned char* sb_ = lds + (slot) * G2_SLOT; _Pragma("unroll") for (int k = 0; k < 4; ++k) { *(v4u*)(sb_ + wo[k]) = RW[k]; *(v4u*)(sb_ + ko[k]) = RK[k]; } } while (0)
        G2_LOAD(r0w, r0k, 0); G2_LOAD(r1w, r1k, 1); G2_LOAD(r2w, r2k, 2); G2_LOAD(r3w, r3k, 3);
        G2_PUT(r0w, r0k, 0); G2_LOAD(r0w, r0k, 4);
        G2_PUT(r1w, r1k, 1); G2_LOAD(r1w, r1k, 5);
        G2_BAR();
        int slot = 2;
#define G2_MOVE(RW, RK, chp) do { if ((chp) + 2 < NCH) { G2_PUT(RW, RK, slot); if ((chp) + 6 < NCH) G2_LOAD(RW, RK, (chp) + 6); } slot = (slot == 2) ? 0 : slot + 1; G2_BAR(); } while (0)
        for (int ch = 0; ch < NCH; ch += 4) { G2_MOVE(r2w, r2k, ch); G2_MOVE(r3w, r3k, ch + 1); G2_MOVE(r0w, r0k, ch + 2); G2_MOVE(r1w, r1k, ch + 3); }
#undef G2_MOVE
#undef G2_LOAD
#undef G2_PUT
        return;
    }
    const int slice = c.wave;
    float* els = (float*)(lds + 3 * G2_SLOT);
    if (c.wave == 0) els[lane] = El[(size_t)bh * 64 + lane];
    f32x16 S[4];
#pragma unroll
    for (int t = 0; t < 4; ++t)
#pragma unroll
        for (int r = 0; r < 16; ++r) S[t][r] = 0.f;
    v4u ua[4], ub[4];
#define G2_ULOAD(UN, ch) do { const bf16* up_ = Ug + ((size_t)bh * 64 + (ch)) * 8192 + (size_t)(slice * 2 * 64 + lane) * 16; UN[0] = *(const GAS v4u*)(up_); UN[1] = *(const GAS v4u*)(up_ + 8); UN[2] = *(const GAS v4u*)(up_ + 1024); UN[3] = *(const GAS v4u*)(up_ + 1032); } while (0)
#define G2_STEP(UN, ch) do { const size_t item = (size_t)bh * 64 + (ch); const unsigned char* sb = lds + slot * G2_SLOT; \
        f32x16 av[2]; \
        _Pragma("unroll") for (int rt = 0; rt < 2; ++rt) _Pragma("unroll") for (int q = 0; q < 2; ++q) { const v4u uu = UN[2 * rt + q]; av[rt][8 * q] = bflo(uu.x); av[rt][8 * q + 1] = bfhi(uu.x); av[rt][8 * q + 2] = bflo(uu.y); av[rt][8 * q + 3] = bfhi(uu.y); av[rt][8 * q + 4] = bflo(uu.z); av[rt][8 * q + 5] = bfhi(uu.z); av[rt][8 * q + 6] = bflo(uu.w); av[rt][8 * q + 7] = bfhi(uu.w); } \
        if ((ch) + 2 < NCH) G2_ULOAD(UN, (ch) + 2); \
        const float el = els[(ch)]; \
        bf16* scp = SCt + item * 16384 + (size_t)(slice * 8 * 64 + lane) * 8;     \
        _Pragma("unroll") for (int t = 0; t < 4; ++t) _Pragma("unroll") for (int s2 = 0; s2 < 2; ++s2) { const int o = 8 * s2; \
                const unsigned p0 = pk2(S[t][o], S[t][o + 1]), p1 = pk2(S[t][o + 2], S[t][o + 3]), p2 = pk2(S[t][o + 4], S[t][o + 5]), p3 = pk2(S[t][o + 6], S[t][o + 7]); \
                const bf16x8 sbf = mk8(p0, p1, p2, p3); v4u sw = {p0, p1, p2, p3}; \
                *(GAS v4u*)(scp + (2 * t + s2) * 512) = sw; \
                const bf16x8 w0 = *(const bf16x8*)(sb + (r32) * 272 + (16 * (2 * t + s2) + 8 * hi) * 2), w1 = *(const bf16x8*)(sb + (32 + r32) * 272 + (16 * (2 * t + s2) + 8 * hi) * 2); \
                av[0] = MFMA32(w0, sbf, av[0]); av[1] = MFMA32(w1, sbf, av[1]); } \
        bf16x8 vb[2][2]; bf16* vnp = VNt + item * 8192 + (size_t)(slice * 4 * 64 + lane) * 8;     \
        _Pragma("unroll") for (int rt = 0; rt < 2; ++rt) _Pragma("unroll") for (int s2 = 0; s2 < 2; ++s2) { const int o = 8 * s2; \
                const unsigned p0 = pk2(av[rt][o], av[rt][o + 1]), p1 = pk2(av[rt][o + 2], av[rt][o + 3]), p2 = pk2(av[rt][o + 4], av[rt][o + 5]), p3 = pk2(av[rt][o + 6], av[rt][o + 7]); \
                vb[rt][s2] = mk8(p0, p1, p2, p3); v4u vw = {p0, p1, p2, p3}; \
                *(GAS v4u*)(vnp + (2 * rt + s2) * 512) = vw; } \
        _Pragma("unroll") for (int t = 0; t < 4; ++t) { \
            _Pragma("unroll") for (int r = 0; r < 16; ++r) S[t][r] *= el; \
            _Pragma("unroll") for (int ks = 0; ks < 4; ++ks) { const bf16x8 kf = *(const bf16x8*)(sb + G2_KD + (32 * t + r32) * 144 + (16 * ks + 8 * hi) * 2); S[t] = MFMA32(kf, vb[ks >> 1][ks & 1], S[t]); } } \
        slot = (slot == 2) ? 0 : slot + 1; \
        G2_BAR(); } while (0)
    G2_ULOAD(ua, 0); G2_ULOAD(ub, 1);
    G2_BAR();
    int slot = 0;
    for (int ch = 0; ch < NCH; ch += 2) { G2_STEP(ua, ch); G2_STEP(ub, ch + 1); }
#undef G2_STEP
#undef G2_ULOAD
#undef G2_BAR
    float* og = a.out + O_PGDN + (size_t)bh * 16384;
#pragma unroll
    for (int t = 0; t < 4; ++t)
#pragma unroll
        for (int r = 0; r < 16; ++r) og[(32 * t + crow(r, hi)) * 128 + 32 * slice + r32] = S[t][r];
}

__device__ __forceinline__ void g3_item(const Args& a, const Ctx& c, unsigned char* lds, int item) {
    const int b = item >> 8, h = (item >> 6) & 3, ch = item & 63, row0 = b * SEQ + ch * 64;
    const int rt = c.wave & 1, ct = c.wave >> 1, r32 = c.lane & 31, hi = c.lane >> 5;
    const bf16* qe = WSP(bf16, G_QE) + (size_t)item * 8192 + (32 * rt + r32) * 128 + 8 * hi;
    const bf16* sc = WSP(bf16, G_SCT) + (size_t)item * 16384 + (size_t)(ct * 8 * 64 + c.lane) * 8;
    const bf16* at = WSP(bf16, G_AT) + (size_t)item * 4096 + (32 * rt + r32) * 64 + 8 * hi;
    const bf16* vn = WSP(bf16, G_VNT) + (size_t)item * 8192 + (size_t)(ct * 4 * 64 + c.lane) * 8;
    f32x16 acc;
#pragma unroll
    for (int r = 0; r < 16; ++r) acc[r] = 0.f;
#pragma unroll
    for (int kk = 0; kk < 8; ++kk) { const bf16x8 av = *(const GAS bf16x8*)(qe + 16 * kk), bv = *(const GAS bf16x8*)(sc + 512 * kk); acc = MFMA32(av, bv, acc); }
#pragma unroll
    for (int kk = 0; kk < 4; ++kk) { const bf16x8 av = *(const GAS bf16x8*)(at + 16 * kk), bv = *(const GAS bf16x8*)(vn + 512 * kk); acc = MFMA32(av, bv, acc); }
    float* Ot = (float*)lds;
#pragma unroll
    for (int r = 0; r < 16; ++r) Ot[(32 * rt + crow(r, hi)) * 132 + 32 * ct + r32] = acc[r];
    __syncthreads();
    { const int i = c.tid >> 3, p8 = c.tid & 7; const float* orow = Ot + i * 132 + p8 * 16; float v[16]; float ssq = 0.f;
#pragma unroll
      for (int q = 0; q < 4; ++q) { const f32x4 t4 = *(const f32x4*)(orow + 4 * q); v[4 * q] = t4.x; v[4 * q + 1] = t4.y; v[4 * q + 2] = t4.z; v[4 * q + 3] = t4.w; }
#pragma unroll
      for (int e = 0; e < 16; ++e) ssq += v[e] * v[e];
      ssq += __shfl_xor(ssq, 1); ssq += __shfl_xor(ssq, 2); ssq += __shfl_xor(ssq, 4);
      const float rstd = rsqrtf(ssq * (1.f / 128.f) + EPSN);
      const bf16* zp = WSP(bf16, A_PROJ) + (size_t)(row0 + i) * PROJW + 1536 + h * 128 + p8 * 16; const v4u z0 = *(const GAS v4u*)zp, z1 = *(const GAS v4u*)(zp + 8);
      const float* gn = a.in[IN_G_NORM] + p8 * 16; float z[16];
      z[0] = bflo(z0.x); z[1] = bfhi(z0.x); z[2] = bflo(z0.y); z[3] = bfhi(z0.y); z[4] = bflo(z0.z); z[5] = bfhi(z0.z); z[6] = bflo(z0.w); z[7] = bfhi(z0.w);
      z[8] = bflo(z1.x); z[9] = bfhi(z1.x); z[10] = bflo(z1.y); z[11] = bfhi(z1.y); z[12] = bflo(z1.z); z[13] = bfhi(z1.z); z[14] = bflo(z1.w); z[15] = bfhi(z1.w);
#pragma unroll
      for (int e = 0; e < 16; ++e) v[e] = v[e] * rstd * gn[e] * siluf(z[e]);
      v4u o0, o1; o0.x = pk2(v[0], v[1]); o0.y = pk2(v[2], v[3]); o0.z = pk2(v[4], v[5]); o0.w = pk2(v[6], v[7]); o1.x = pk2(v[8], v[9]); o1.y = pk2(v[10], v[11]); o1.z = pk2(v[12], v[13]); o1.w = pk2(v[14], v[15]);
      bf16* dst = WSP(bf16, A_MIX) + (size_t)(row0 + i) * DM + h * 128 + p8 * 16; *(GAS v4u*)dst = o0; *(GAS v4u*)(dst + 8) = o1; }
    __syncthreads();
}
constexpr int SS_XT = 0, SS_B = 36864, SS_C = 54272, SS_DT = 71680, SS_CUM = 72704, SS_EDEC = 73728, SS_ECUM = 74752, SS_END = 75776;
template <int MODE> __device__ __forceinline__ void ssd_load(const Args& a, const Ctx& c, unsigned char* lds, int item) {
    const int b = item >> 7, grp = (item >> 6) & 1, ch = item & 63, row0 = b * SEQ + ch * 64;
    float* dtv = (float*)(lds + SS_DT); float* cumv = (float*)(lds + SS_CUM); float* edec = (float*)(lds + SS_EDEC); float* ecum = (float*)(lds + SS_ECUM);
    const float* GATES = WSP(float, A_GATES);
    if (c.wave < 4) { const int hd = grp * 4 + c.wave, i = c.lane;
        const float dt = softplusf(GATES[(size_t)(row0 + i) * 16 + 8 + hd] + a.in[IN_S_DTB][hd]); const float la = -__expf(a.in[IN_S_ALOG][hd]) * dt;
        float cs = la;
#pragma unroll
        for (int o = 1; o < 64; o <<= 1) { const float t2 = __shfl_up(cs, o); if (c.lane >= o) cs += t2; }
        const float last = __shfl(cs, 63);
        dtv[c.wave * 64 + i] = dt; cumv[c.wave * 64 + i] = cs; edec[c.wave * 64 + i] = __expf(last - cs); ecum[c.wave * 64 + i] = __expf(cs);
        if (MODE == 1 && c.lane == 0) WSP(float, S_ELAST)[((size_t)b * 8 + hd) * 64 + ch] = __expf(last); }
    __syncthreads();
    const bf16* PROJ = WSP(bf16, A_PROJ); const float* cw = a.in[IN_CONV_SW]; const float* cb = a.in[IN_CONV_SB];
    bf16* XT = (bf16*)(lds + SS_XT); bf16* Bx = (bf16*)(lds + SS_B); bf16* Cx = (bf16*)(lds + SS_C);
    const int i = c.tid >> 3, g8 = c.tid & 7, t = ch * 64 + i;
#pragma unroll
    for (int sb = 0; sb < 4; ++sb) {
        if (MODE == 1 && sb == 3) continue;
        const int q0 = sb * 128 + g8 * 16;
        const int chx = (q0 < 256) ? grp * 256 + q0 : (q0 < 384 ? 512 + grp * 128 + (q0 - 256) : 768 + grp * 128 + (q0 - 384));
        float acc[16];
        { const float* bp = cb + chx; const f32x4 b0 = *(const GAS f32x4*)bp, b1 = *(const GAS f32x4*)(bp + 4), b2 = *(const GAS f32x4*)(bp + 8), b3 = *(const GAS f32x4*)(bp + 12);
          acc[0] = b0.x; acc[1] = b0.y; acc[2] = b0.z; acc[3] = b0.w; acc[4] = b1.x; acc[5] = b1.y; acc[6] = b1.z; acc[7] = b1.w;
          acc[8] = b2.x; acc[9] = b2.y; acc[10] = b2.z; acc[11] = b2.w; acc[12] = b3.x; acc[13] = b3.y; acc[14] = b3.z; acc[15] = b3.w; }
#pragma unroll
        for (int tap = 0; tap < 4; ++tap) { const int tt = t - 3 + tap; const float ok = (tt >= 0) ? 1.0f : 0.0f;
            { const bf16* src = PROJ + (size_t)(b * SEQ + (tt >= 0 ? tt : 0)) * PROJW + 2560 + chx; const v4u x0 = *(const GAS v4u*)src, x1 = *(const GAS v4u*)(src + 8);
                const float* wp = cw + tap * 1024 + chx; const f32x4 w0 = *(const GAS f32x4*)wp * ok, w1 = *(const GAS f32x4*)(wp + 4) * ok, w2 = *(const GAS f32x4*)(wp + 8) * ok, w3 = *(const GAS f32x4*)(wp + 12) * ok;
                acc[0] += w0.x * bflo(x0.x); acc[1] += w0.y * bfhi(x0.x); acc[2] += w0.z * bflo(x0.y); acc[3] += w0.w * bfhi(x0.y);
                acc[4] += w1.x * bflo(x0.z); acc[5] += w1.y * bfhi(x0.z); acc[6] += w1.z * bflo(x0.w); acc[7] += w1.w * bfhi(x0.w);
                acc[8] += w2.x * bflo(x1.x); acc[9] += w2.y * bfhi(x1.x); acc[10] += w2.z * bflo(x1.y); acc[11] += w2.w * bfhi(x1.y);
                acc[12] += w3.x * bflo(x1.z); acc[13] += w3.y * bfhi(x1.z); acc[14] += w3.z * bflo(x1.w); acc[15] += w3.w * bfhi(x1.w); } }
#pragma unroll
        for (int e = 0; e < 16; ++e) acc[e] = siluf(acc[e]);
        if (sb < 2) { const int hh = q0 >> 6; const float sc = (MODE == 1) ? dtv[hh * 64 + i] * edec[hh * 64 + i] : 1.0f;
#pragma unroll
            for (int e = 0; e < 16; ++e) XT[(q0 + e) * 72 + i] = (bf16)f2bf(acc[e] * sc); }
        else if (MODE == 1) {
#pragma unroll
            for (int e = 0; e < 16; ++e) Bx[(q0 - 256 + e) * 72 + i] = (bf16)f2bf(acc[e]); }
        else { bf16* dst = (sb == 2 ? Bx : Cx) + i * 136 + (q0 & 127);
            v4u o0, o1; o0.x = pk2(acc[0], acc[1]); o0.y = pk2(acc[2], acc[3]); o0.z = pk2(acc[4], acc[5]); o0.w = pk2(acc[6], acc[7]); o1.x = pk2(acc[8], acc[9]); o1.y = pk2(acc[10], acc[11]); o1.z = pk2(acc[12], acc[13]); o1.w = pk2(acc[14], acc[15]);
            *(v4u*)dst = o0; *(v4u*)(dst + 8) = o1; }
    }
    __syncthreads();
}
__device__ __forceinline__ void s1_item(const Args& a, const Ctx& c, unsigned char* lds, int item) {
    ssd_load<1>(a, c, lds, item);
    const int b = item >> 7, grp = (item >> 6) & 1, ch = item & 63;
    const bf16* XT = (const bf16*)(lds + SS_XT); const bf16* BT = (const bf16*)(lds + SS_B);
    const int hh = c.wave >> 1, pt = c.wave & 1, r32 = c.lane & 31, hi = c.lane >> 5;
    bf16* st = WSP(bf16, S_STATES) + (((size_t)b * 8 + grp * 4 + hh) * 64 + ch) * 8192;
    bf16x8 af[4];
#pragma unroll
    for (int ks = 0; ks < 4; ++ks) af[ks] = *(const bf16x8*)(XT + (hh * 64 + 32 * pt + r32) * 72 + 16 * ks + 8 * hi);
#pragma unroll
    for (int nt = 0; nt < 4; ++nt) { f32x16 acc;
#pragma unroll
        for (int r = 0; r < 16; ++r) acc[r] = 0.f;
#pragma unroll
        for (int ks = 0; ks < 4; ++ks) { const bf16x8 bv = *(const bf16x8*)(BT + (32 * nt + r32) * 72 + 16 * ks + 8 * hi); acc = MFMA32(af[ks], bv, acc); }
#pragma unroll
        for (int r = 0; r < 16; ++r) st[(32 * pt + crow(r, hi)) * 128 + 32 * nt + r32] = (bf16)f2bf(acc[r]); }
    __syncthreads();
}
__device__ __forceinline__ void s2_task(const Args& a, int task) {
    const int bh = task >> 11, e4 = (task & 2047) * 4;
    const bf16* st = WSP(bf16, S_STATES) + (size_t)bh * 64 * 8192 + e4; const float* el = WSP(float, S_ELAST) + (size_t)bh * 64; bf16* hc = WSP(bf16, S_HC) + (size_t)bh * 64 * 8192 + e4;
    f32x4 h = {0.f, 0.f, 0.f, 0.f};
    for (int c0 = 0; c0 < NCH; c0 += 16) {
        v2u sv[16]; float ev[16];
#pragma unroll
        for (int j = 0; j < 16; ++j) { sv[j] = *(const GAS v2u*)(st + (size_t)(c0 + j) * 8192); ev[j] = el[c0 + j]; }
#pragma unroll
        for (int j = 0; j < 16; ++j) { v2u o; o.x = pk2(h.x, h.y); o.y = pk2(h.z, h.w); *(GAS v2u*)(hc + (size_t)(c0 + j) * 8192) = o;
            const f32x4 sj = {bflo(sv[j].x), bfhi(sv[j].x), bflo(sv[j].y), bfhi(sv[j].y)}; h = h * ev[j] + sj; } }
    *(GAS f32x4*)(a.out + O_PSSM + (size_t)bh * 8192 + e4) = h;
}
constexpr int S3_CB = SS_END, S3_SC = S3_CB + 64 * 65 * 4  , S3_END = S3_SC + 4 * 64 * 72 * 2  ;
static_assert(S3_END <= RING_BYTES, "S3 LDS");
__device__ __forceinline__ void s3_item(const Args& a, const Ctx& c, unsigned char* lds, int item) {
    ssd_load<3>(a, c, lds, item);
    const int b = item >> 7, grp = (item >> 6) & 1, ch = item & 63, row0 = b * SEQ + ch * 64;
    const bf16* XT = (const bf16*)(lds + SS_XT); const bf16* Bm = (const bf16*)(lds + SS_B); const bf16* Cm = (const bf16*)(lds + SS_C);
    const float* dtv = (const float*)(lds + SS_DT); const float* cumv = (const float*)(lds + SS_CUM); const float* ecum = (const float*)(lds + SS_ECUM);
    float* CB = (float*)(lds + S3_CB); bf16* Sc = (bf16*)(lds + S3_SC);
    const int r32 = c.lane & 31, hi = c.lane >> 5;
    if (c.wave < 4) { const int ti = c.wave & 1, tj = c.wave >> 1; f32x16 acc;
#pragma unroll
        for (int r = 0; r < 16; ++r) acc[r] = 0.f;
        if (ti >= tj) {
#pragma unroll
            for (int kk = 0; kk < 8; ++kk) { const bf16x8 av = *(const bf16x8*)(Cm + (32 * ti + r32) * 136 + 16 * kk + 8 * hi), bv = *(const bf16x8*)(Bm + (32 * tj + r32) * 136 + 16 * kk + 8 * hi); acc = MFMA32(av, bv, acc); } }
#pragma unroll
        for (int r = 0; r < 16; ++r) CB[(32 * ti + crow(r, hi)) * 65 + 32 * tj + r32] = acc[r]; }
    __syncthreads();
#pragma unroll 4
    for (int k = 0; k < 32; ++k) { const int idx = c.tid + 512 * k, hh = idx >> 12, i = (idx >> 6) & 63, j = idx & 63;
        const float v = (i >= j) ? CB[i * 65 + j] * __expf(cumv[hh * 64 + i] - cumv[hh * 64 + j]) * dtv[hh * 64 + j] : 0.f;
        Sc[(hh * 64 + i) * 72 + j] = (bf16)f2bf(v); }
    __syncthreads();
    const int hh = c.wave >> 1, pt = c.wave & 1, hd = grp * 4 + hh;
    const bf16* hcp = WSP(bf16, S_HC) + (((size_t)b * 8 + hd) * 64 + ch) * 8192 + (size_t)(32 * pt + r32) * 128 + 8 * hi;
    f32x16 y[2];
#pragma unroll
    for (int it = 0; it < 2; ++it) { f32x16 a1, a2;
#pragma unroll
        for (int r = 0; r < 16; ++r) { a1[r] = 0.f; a2[r] = 0.f; }
#pragma unroll
        for (int ks = 0; ks < 4; ++ks) { const bf16x8 av = *(const bf16x8*)(Sc + (hh * 64 + 32 * it + r32) * 72 + 16 * ks + 8 * hi), bv = *(const bf16x8*)(XT + (hh * 64 + 32 * pt + r32) * 72 + 16 * ks + 8 * hi); a1 = MFMA32(av, bv, a1); }
#pragma unroll
        for (int kk = 0; kk < 8; ++kk) { const bf16x8 av = *(const bf16x8*)(Cm + (32 * it + r32) * 136 + 16 * kk + 8 * hi), bv = *(const GAS bf16x8*)(hcp + 16 * kk); a2 = MFMA32(av, bv, a2); }
#pragma unroll
        for (int r = 0; r < 16; ++r) y[it][r] = a1[r] + ecum[hh * 64 + 32 * it + crow(r, hi)] * a2[r]; }
    { const int chn = hh * 64 + 32 * pt + r32; const float Dh = a.in[IN_S_D][hd]; const bf16* PROJ = WSP(bf16, A_PROJ);
#pragma unroll
      for (int it = 0; it < 2; ++it)
#pragma unroll
          for (int r = 0; r < 16; ++r) { const int i = 32 * it + crow(r, hi); const float xs = bf2f(XT[chn * 72 + i]); y[it][r] = y[it][r] + Dh * xs; } }
    __syncthreads();
    float* Y = (float*)lds;
    { const int chn = hh * 64 + 32 * pt + r32;
#pragma unroll
      for (int it = 0; it < 2; ++it)
#pragma unroll
          for (int r = 0; r < 16; ++r) Y[(32 * it + crow(r, hi)) * 260 + chn] = y[it][r]; }
    __syncthreads();
    { const int i = c.tid >> 3, p8 = c.tid & 7; const float* yr = Y + i * 260 + p8 * 32; float v[32]; float ssq = 0.f;
#pragma unroll
      for (int q = 0; q < 8; ++q) { const f32x4 t4 = *(const f32x4*)(yr + 4 * q); v[4 * q] = t4.x; v[4 * q + 1] = t4.y; v[4 * q + 2] = t4.z; v[4 * q + 3] = t4.w; }
      { const bf16* zp = WSP(bf16, A_PROJ) + (size_t)(row0 + i) * PROJW + 2048 + grp * 256 + p8 * 32;
#pragma unroll
        for (int q = 0; q < 4; ++q) { const v4u zz = *(const GAS v4u*)(zp + 8 * q);
            v[8 * q] *= siluf(bflo(zz.x)); v[8 * q + 1] *= siluf(bfhi(zz.x)); v[8 * q + 2] *= siluf(bflo(zz.y)); v[8 * q + 3] *= siluf(bfhi(zz.y));
            v[8 * q + 4] *= siluf(bflo(zz.z)); v[8 * q + 5] *= siluf(bfhi(zz.z)); v[8 * q + 6] *= siluf(bflo(zz.w)); v[8 * q + 7] *= siluf(bfhi(zz.w)); } }
#pragma unroll
      for (int e = 0; e < 32; ++e) ssq += v[e] * v[e];
      ssq += __shfl_xor(ssq, 1); ssq += __shfl_xor(ssq, 2); ssq += __shfl_xor(ssq, 4);
      const float rstd = rsqrtf(ssq * (1.f / 256.f) + EPSN); const float* gn = a.in[IN_S_NORM] + grp * 256 + p8 * 32;
      bf16* dst = WSP(bf16, A_MIX) + (size_t)(row0 + i) * DM + 512 + grp * 256 + p8 * 32;
#pragma unroll
      for (int q = 0; q < 4; ++q) { v4u o; o.x = pk2(v[8 * q] * rstd * gn[8 * q], v[8 * q + 1] * rstd * gn[8 * q + 1]); o.y = pk2(v[8 * q + 2] * rstd * gn[8 * q + 2], v[8 * q + 3] * rstd * gn[8 * q + 3]);
          o.z = pk2(v[8 * q + 4] * rstd * gn[8 * q + 4], v[8 * q + 5] * rstd * gn[8 * q + 5]); o.w = pk2(v[8 * q + 6] * rstd * gn[8 * q + 6], v[8 * q + 7] * rstd * gn[8 * q + 7]); *(GAS v4u*)(dst + 8 * q) = o; } }
    __syncthreads();
}

__device__ __forceinline__ void gdn_dec_item(const Args& a, const Ctx& c, unsigned char* lds, int item) {
    const int b = item >> 2, h = item & 3, row = MP + b;
    float* qkv = (float*)lds;
    float* red = qkv + 384;
    float* kS = red + 16;
    float* qS = kS + 512;
    float* ov = qS + 512;
    const bf16* PROJ = WSP(bf16, A_PROJ); const float* GATES = WSP(float, A_GATES);
    const float* st_c = a.in[IN_SGC] + (size_t)b * 3 * 1536; const float* cw = a.in[IN_CONV_GW];
    const int rg = c.tid >> 7, col = c.tid & 127;
    const float* S0 = a.in[IN_SGDN] + ((size_t)b * 4 + h) * 16384;
    float s[32];
#pragma unroll
    for (int rr = 0; rr < 32; ++rr) s[rr] = S0[(rg * 32 + rr) * 128 + col];
    if (c.tid < 384) { const int X = c.tid >> 7, d = c.tid & 127, chn = X * 512 + h * 128 + d;
        const float xn = bf2f(PROJ[(size_t)row * PROJW + chn]);
        const float s0 = st_c[chn], s1 = st_c[1536 + chn], s2 = st_c[3072 + chn];
        float y = cw[chn] * s0 + cw[1536 + chn] * s1 + cw[3072 + chn] * s2 + cw[4608 + chn] * xn;
        y = siluf(y); qkv[c.tid] = y;
        float* oc = a.out + O_SGC + (size_t)b * 3 * 1536; oc[chn] = s1; oc[1536 + chn] = s2; oc[3072 + chn] = xn;
        const float ss = wave_sum(y * y); if (c.lane == 0) red[c.wave] = ss; }
    __syncthreads();
    const float rq = rsqrtf(red[0] + red[1] + EPSN) * 0.08838834764831845f, rk = rsqrtf(red[2] + red[3] + EPSN);
    const float ga = GATES[(size_t)row * 16 + h], gb = GATES[(size_t)row * 16 + 4 + h];
    const float g = -__expf(a.in[IN_G_ALOG][h]) * softplusf(ga + a.in[IN_G_DTB][h]), beta = sigmoidf(gb), eg = __expf(g);
    float pk_ = 0.f, pq_ = 0.f;
#pragma unroll
    for (int rr = 0; rr < 32; ++rr) { const int dk = rg * 32 + rr; pk_ += qkv[128 + dk] * rk * s[rr]; pq_ += qkv[dk] * rq * s[rr]; }
    kS[rg * 128 + col] = pk_; qS[rg * 128 + col] = pq_;
    if (c.wave < 2) { const float qk = wave_sum(qkv[c.tid] * rq * qkv[128 + c.tid] * rk); if (c.lane == 0) red[8 + c.wave] = qk; }
    __syncthreads();
    const float kSt = kS[col] + kS[128 + col] + kS[256 + col] + kS[384 + col], qSt = qS[col] + qS[128 + col] + qS[256 + col] + qS[384 + col];
    const float qk = red[8] + red[9];
    const float vnew = beta * (qkv[256 + col] - eg * kSt);
    const float o = eg * qSt + qk * vnew;
    float* So = a.out + O_SGDN + ((size_t)b * 4 + h) * 16384;
#pragma unroll
    for (int rr = 0; rr < 32; ++rr) { const int dk = rg * 32 + rr; So[dk * 128 + col] = s[rr] * eg + qkv[128 + dk] * rk * vnew; }
    if (rg == 0) { ov[col] = o; const float ss = wave_sum(o * o); if (c.lane == 0) red[12 + c.wave] = ss; }
    __syncthreads();
    if (rg == 0) { const float rstd = rsqrtf((red[12] + red[13]) * (1.f / 128.f) + EPSN);
        const float z = bf2f(PROJ[(size_t)row * PROJW + 1536 + h * 128 + col]);
        WSP(bf16, A_MIX)[(size_t)row * DM + h * 128 + col] = (bf16)f2bf(ov[col] * rstd * a.in[IN_G_NORM][col] * siluf(z)); }
    __syncthreads();
}
__device__ __forceinline__ void ssd_dec_item(const Args& a, const Ctx& c, unsigned char* lds, int item) {
    const int b = item >> 1, grp = item & 1, row = MP + b;
    float* xbc = (float*)lds;
    float* red = xbc + 512;
    float* yv = red + 16;
    const bf16* PROJ = WSP(bf16, A_PROJ); const float* GATES = WSP(float, A_GATES);
    const float* st_c = a.in[IN_SSC] + (size_t)b * 3 * 1024; const float* cw = a.in[IN_CONV_SW];
    const int hh = c.tid >> 7, hd = grp * 4 + hh, p = (c.tid & 127) >> 1, half = c.tid & 1;
    const float* h0 = a.in[IN_SSSM] + (((size_t)b * 8 + hd) * 64 + p) * 128 + half * 64; float* ho = a.out + O_SSSM + (((size_t)b * 8 + hd) * 64 + p) * 128 + half * 64;
    f32x4 hv[16];
#pragma unroll
    for (int q = 0; q < 16; ++q) hv[q] = *(const GAS f32x4*)(h0 + 4 * q);
    { const int q = c.tid; const int chx = (q < 256) ? grp * 256 + q : (q < 384 ? 512 + grp * 128 + (q - 256) : 768 + grp * 128 + (q - 384));
      const float xn = bf2f(PROJ[(size_t)row * PROJW + 2560 + chx]);
      const float s0 = st_c[chx], s1 = st_c[1024 + chx], s2 = st_c[2048 + chx];
      float y = cw[chx] * s0 + cw[1024 + chx] * s1 + cw[2048 + chx] * s2 + cw[3072 + chx] * xn + a.in[IN_CONV_SB][chx];
      xbc[q] = siluf(y);
      float* oc = a.out + O_SSC + (size_t)b * 3 * 1024; oc[chx] = s1; oc[1024 + chx] = s2; oc[2048 + chx] = xn; }
    __syncthreads();
    const float dt = softplusf(GATES[(size_t)row * 16 + 8 + hd] + a.in[IN_S_DTB][hd]); const float ela = __expf(-__expf(a.in[IN_S_ALOG][hd]) * dt);
    const float xs = xbc[hh * 64 + p], xdt = xs * dt;
    float yp = 0.f;
#pragma unroll
    for (int q = 0; q < 16; ++q) { const int n = half * 64 + 4 * q; f32x4 hn;
        hn.x = hv[q].x * ela + xdt * xbc[256 + n]; hn.y = hv[q].y * ela + xdt * xbc[256 + n + 1]; hn.z = hv[q].z * ela + xdt * xbc[256 + n + 2]; hn.w = hv[q].w * ela + xdt * xbc[256 + n + 3];
        yp += hn.x * xbc[384 + n] + hn.y * xbc[384 + n + 1] + hn.z * xbc[384 + n + 2] + hn.w * xbc[384 + n + 3];
        *(GAS f32x4*)(ho + 4 * q) = hn; }
    yp += __shfl_xor(yp, 1);
    const float z = bf2f(PROJ[(size_t)row * PROJW + 2048 + grp * 256 + hh * 64 + p]);
    const float yy = (yp + a.in[IN_S_D][hd] * xs) * siluf(z);
    const float ss = wave_sum(half == 0 ? yy * yy : 0.f); if (c.lane == 0) red[c.wave] = ss;
    if (half == 0) yv[hh * 64 + p] = yy;
    __syncthreads();
    if (c.tid < 256) { float tot = 0.f;
#pragma unroll
        for (int w = 0; w < 8; ++w) tot += red[w];
        const float rstd = rsqrtf(tot * (1.f / 256.f) + EPSN);
        WSP(bf16, A_MIX)[(size_t)row * DM + 512 + grp * 256 + c.tid] = (bf16)f2bf(yv[c.tid] * rstd * a.in[IN_S_NORM][grp * 256 + c.tid]); }
    __syncthreads();
}
__device__ __forceinline__ void prompt_conv_out(const Args& a, int idx) {
    const bf16* PROJ = WSP(bf16, A_PROJ);
    if (idx < 4 * 3 * 1536) { const int b = idx / 4608, r = (idx / 1536) % 3, chn = idx % 1536; a.out[O_PGC + idx] = bf2f(PROJ[(size_t)(b * SEQ + SEQ - 3 + r) * PROJW + chn]); }
    else { const int k = idx - 4 * 3 * 1536; const int b = k / 3072, r = (k / 1024) % 3, chn = k % 1024; a.out[O_PSC + k] = bf2f(PROJ[(size_t)(b * SEQ + SEQ - 3 + r) * PROJW + 2560 + chn]); }
}
__device__ __forceinline__ float rope_invfreq(int f) { return __builtin_amdgcn_exp2f(-(float)f * (13.287712379549449f / 16.0f)); }
struct C2In { f32x4 q0, q1, cv; float krv; };
__device__ __forceinline__ C2In c2_load(const Args& a, int m, int lane) { const float* src = WSP(float, C_CKV) + (size_t)m * DM; C2In r;
    r.q0 = *(const GAS f32x4*)(src + 4 * lane); r.q1 = *(const GAS f32x4*)(src + 256 + 4 * lane); r.cv = *(const GAS f32x4*)(src + 512 + 4 * lane); r.krv = src[768 + (lane & 31)]; return r; }
__device__ __forceinline__ void c2_row(const Args& a, int m, int lane, const C2In& in) {
    float* rows = (m < MP) ? a.out + O_PROWS + (size_t)m * ROWW : a.out + O_SROWS + (size_t)(m - MP) * ROWW;
    const float pos = (m < MP) ? (float)(m & (SEQ - 1)) : (float)PASTLEN;
    const f32x4 q0 = in.q0, q1 = in.q1, cv = in.cv;
    const float krv = (lane < 32) ? in.krv : 0.f;
    const float sq = wave_sum((q0.x * q0.x + q0.y * q0.y) + (q0.z * q0.z + q0.w * q0.w) + (q1.x * q1.x + q1.y * q1.y) + (q1.z * q1.z + q1.w * q1.w));
    const float sc = wave_sum((cv.x * cv.x + cv.y * cv.y) + (cv.z * cv.z + cv.w * cv.w));
    const float sk = wave_sum(krv * krv);
    const float rq = rsqrtf(sq * (1.f / 512.f) + EPSN), rc = rsqrtf(sc * (1.f / 256.f) + EPSN);
    { const f32x4 g0 = *(const GAS f32x4*)(a.in[IN_QA_NORM] + 4 * lane), g1 = *(const GAS f32x4*)(a.in[IN_QA_NORM] + 256 + 4 * lane);
      bf16* o = WSP(bf16, C_CQN) + (size_t)m * 512; v2u w0 = {pk2(q0.x * rq * g0.x, q0.y * rq * g0.y), pk2(q0.z * rq * g0.z, q0.w * rq * g0.w)}, w1 = {pk2(q1.x * rq * g1.x, q1.y * rq * g1.y), pk2(q1.z * rq * g1.z, q1.w * rq * g1.w)};
      *(GAS v2u*)(o + 4 * lane) = w0; *(GAS v2u*)(o + 256 + 4 * lane) = w1; }
    { const f32x4 g = *(const GAS f32x4*)(a.in[IN_KVA_NORM] + 4 * lane); const f32x4 y = cv * rc * g;
      *(GAS f32x4*)(rows + 4 * lane) = y; v2u w = {pk2(y.x, y.y), pk2(y.z, y.w)}; *(GAS v2u*)(WSP(bf16, C_CN) + (size_t)m * 256 + 4 * lane) = w; }
    { const int f = lane & 15; const float xk = (lane < 32) ? krv * a.in[IN_K_NORM][64 + lane] : 0.f; const float other = __shfl_xor(xk, 16);
      float sn, cs; sincosf(pos * rope_invfreq(f), &sn, &cs);
      const float out = (lane < 16) ? xk * cs - other * sn : xk * cs + other * sn;
      float* krx = WSP(float, C_KRX) + (size_t)m * 64;
      if (lane < 32) { rows[256 + lane] = out; krx[lane] = out; } if (lane == 32) krx[32] = sk; }
}
struct QIn { v4u x[3]; };
__device__ __forceinline__ QIn q_load(const bf16* qraw_row, int lane) { const int hq = lane >> 2, part = lane & 3; const bf16* s = qraw_row + hq * 96 + part * 24; QIn r;
#pragma unroll
    for (int q = 0; q < 3; ++q) r.x[q] = *(const GAS v4u*)(s + 8 * q);
    return r; }
__device__ __forceinline__ void q_head_to_lds(const Args& a, const QIn& qi, float pos, float* scr, int lane) {
    const int hq = lane >> 2, part = lane & 3; float v[24];
#pragma unroll
    for (int q = 0; q < 3; ++q) { const v4u x = qi.x[q]; v[8 * q] = bflo(x.x); v[8 * q + 1] = bfhi(x.x); v[8 * q + 2] = bflo(x.y); v[8 * q + 3] = bfhi(x.y); v[8 * q + 4] = bflo(x.z); v[8 * q + 5] = bfhi(x.z); v[8 * q + 6] = bflo(x.w); v[8 * q + 7] = bfhi(x.w); }
    float ssq = 0.f;
#pragma unroll
    for (int e = 0; e < 24; ++e) ssq += v[e] * v[e];
    ssq += __shfl_xor(ssq, 1); ssq += __shfl_xor(ssq, 2);
    const float rstd = rsqrtf(ssq * (1.f / 96.f) + EPSN); const float* qn = a.in[IN_Q_NORM] + part * 24;
#pragma unroll
    for (int e = 0; e < 24; ++e) scr[hq * 96 + part * 24 + e] = v[e] * rstd * qn[e];
    LDS_WAIT();
#pragma unroll
    for (int j = 0; j < 4; ++j) { const int pp = lane + 64 * j, hh = pp >> 4, f = pp & 15; float sn, cs; sincosf(pos * rope_invfreq(f), &sn, &cs);
        const float x1 = scr[hh * 96 + 64 + f], x2 = scr[hh * 96 + 80 + f]; LDS_WAIT();
        scr[hh * 96 + 64 + f] = x1 * cs - x2 * sn; scr[hh * 96 + 80 + f] = x2 * cs + x1 * sn; }
    LDS_WAIT();
}
struct C5In { QIn q; v4u k0, k1; f32x4 cv; float krv, ssc; };
__device__ __forceinline__ C5In c5_load(const Args& a, int m, int lane) { C5In r; r.q = q_load(WSP(bf16, C_QRAW) + (size_t)m * QP, lane);
    const int hq = lane >> 2, part = lane & 3; const bf16* s = WSP(bf16, C_KN) + (size_t)m * 1024 + hq * 64 + part * 16; r.k0 = *(const GAS v4u*)s; r.k1 = *(const GAS v4u*)(s + 8);
    const float* src = WSP(float, C_CKV) + (size_t)m * DM; r.cv = *(const GAS f32x4*)(src + 512 + 4 * lane); r.krv = src[768 + (lane & 31)];
    r.ssc = ((const float*)(a.ws + WS_CTL) + CW_SSQ + 4 * MT)[m]; return r; }
__device__ __forceinline__ void c5_row(const Args& a, int m, int lane, float* scr, const C5In& in) {
    const float pos = (m < MP) ? (float)(m & (SEQ - 1)) : (float)PASTLEN;
    float* rows = (m < MP) ? a.out + O_PROWS + (size_t)m * ROWW : a.out + O_SROWS + (size_t)(m - MP) * ROWW;
    { const float rc = rsqrtf(in.ssc * (1.f / 256.f) + EPSN); const f32x4 g = *(const GAS f32x4*)(a.in[IN_KVA_NORM] + 4 * lane); *(GAS f32x4*)(rows + 4 * lane) = in.cv * rc * g; }
    const float krv = (lane < 32) ? in.krv : 0.f; const float skr = wave_sum(krv * krv);
    { const int f = lane & 15; const float xk = (lane < 32) ? krv * a.in[IN_K_NORM][64 + lane] : 0.f; const float other = __shfl_xor(xk, 16);
      float sn, cs; sincosf(pos * rope_invfreq(f), &sn, &cs);
      const float out = (lane < 16) ? xk * cs - other * sn : xk * cs + other * sn;
      if (lane < 32) { rows[256 + lane] = out; scr[1536 + lane] = out; } }
    q_head_to_lds(a, in.q, pos, scr, lane);
    { const int hq = lane >> 2, part = lane & 3; const float* s = scr + hq * 96 + part * 24; bf16* o = WSP(bf16, C_QF) + (size_t)m * QP + hq * 96 + part * 24;
#pragma unroll
      for (int q = 0; q < 3; ++q) { v4u w; w.x = pk2(s[8 * q] * QSCALE, s[8 * q + 1] * QSCALE); w.y = pk2(s[8 * q + 2] * QSCALE, s[8 * q + 3] * QSCALE); w.z = pk2(s[8 * q + 4] * QSCALE, s[8 * q + 5] * QSCALE); w.w = pk2(s[8 * q + 6] * QSCALE, s[8 * q + 7] * QSCALE);
          *(GAS v4u*)(o + 8 * q) = w; } }
    LDS_WAIT();
    { const int hq = lane >> 2, part = lane & 3; const v4u x0 = in.k0, x1 = in.k1; float v[16];
      v[0] = bflo(x0.x); v[1] = bfhi(x0.x); v[2] = bflo(x0.y); v[3] = bfhi(x0.y); v[4] = bflo(x0.z); v[5] = bfhi(x0.z); v[6] = bflo(x0.w); v[7] = bfhi(x0.w);
      v[8] = bflo(x1.x); v[9] = bfhi(x1.x); v[10] = bflo(x1.y); v[11] = bfhi(x1.y); v[12] = bflo(x1.z); v[13] = bfhi(x1.z); v[14] = bflo(x1.w); v[15] = bfhi(x1.w);
      float ssq = 0.f;
#pragma unroll
      for (int e = 0; e < 16; ++e) ssq += v[e] * v[e];
      ssq += __shfl_xor(ssq, 1); ssq += __shfl_xor(ssq, 2);
      const float ir = rsqrtf((ssq + skr) * (1.f / 96.f) + EPSN);
      if (part == 0) rows[288 + hq] = ir;
      const float* kn = a.in[IN_K_NORM] + part * 16; bf16* o = WSP(bf16, C_KF) + (size_t)m * QP + hq * 96;
      v4u w0, w1; w0.x = pk2(v[0] * kn[0] * ir, v[1] * kn[1] * ir); w0.y = pk2(v[2] * kn[2] * ir, v[3] * kn[3] * ir); w0.z = pk2(v[4] * kn[4] * ir, v[5] * kn[5] * ir); w0.w = pk2(v[6] * kn[6] * ir, v[7] * kn[7] * ir);
      w1.x = pk2(v[8] * kn[8] * ir, v[9] * kn[9] * ir); w1.y = pk2(v[10] * kn[10] * ir, v[11] * kn[11] * ir); w1.z = pk2(v[12] * kn[12] * ir, v[13] * kn[13] * ir); w1.w = pk2(v[14] * kn[14] * ir, v[15] * kn[15] * ir);
      *(GAS v4u*)(o + part * 16) = w0; *(GAS v4u*)(o + part * 16 + 8) = w1;
      const f32x4 k0 = *(const f32x4*)(scr + 1536 + part * 8), k1 = *(const f32x4*)(scr + 1536 + part * 8 + 4);
      v4u w2; w2.x = pk2(k0.x * ir, k0.y * ir); w2.y = pk2(k0.z * ir, k0.w * ir); w2.z = pk2(k1.x * ir, k1.y * ir); w2.w = pk2(k1.z * ir, k1.w * ir);
      *(GAS v4u*)(o + 64 + part * 8) = w2; }
}
__device__ __forceinline__ void qcat_item(const Args& a, int item, int lane, float* scr) {
    const int b = item >> 4, h = item & 15, m = MP + b;
    q_head_to_lds(a, q_load(WSP(bf16, C_QRAW) + (size_t)m * QP, lane), (float)PASTLEN, scr, lane);
    const float* qh = scr + h * 96; bf16* o = WSP(bf16, D_QCAT) + ((size_t)b * 16 + h) * 288;
    const float* kn = a.in[IN_K_NORM]; const float* wuk = a.in[IN_W_UK];
#pragma unroll
    for (int j = 0; j < 4; ++j) { const int cc = lane + 64 * j; const float* wr = wuk + (size_t)cc * 1024 + h * 64; float acc = 0.f;
#pragma unroll
        for (int q = 0; q < 16; ++q) { const f32x4 w = *(const GAS f32x4*)(wr + 4 * q); acc += qh[4 * q] * kn[4 * q] * w.x + qh[4 * q + 1] * kn[4 * q + 1] * w.y + qh[4 * q + 2] * kn[4 * q + 2] * w.z + qh[4 * q + 3] * kn[4 * q + 3] * w.w; }
        o[cc] = (bf16)f2bf(acc * QSCALE); }
    if (lane < 32) o[256 + lane] = (bf16)f2bf(qh[64 + lane] * QSCALE);
    LDS_WAIT();
}

constexpr int AT_NSLOT = 4, AT_KB = 16384, AT_SLOT = AT_KB + 8192, AT_OST = AT_NSLOT * AT_SLOT, AT_END = AT_OST + 8 * 4096, AT_WS = RING_BYTES + 1024  ;
static_assert(AT_END <= RING_BYTES && AT_WS + 8 * 256 <= LDS_BYTES, "attention LDS");
__device__ __forceinline__ void glds16(const void* gsrc, unsigned lds_dst) { unsigned keep;
    asm volatile("s_mov_b32 %0, m0\n\ts_mov_b32 m0, %2\n\ts_nop 0\n\tglobal_load_lds_dwordx4 %1, off\n\ts_mov_b32 m0, %0" : "=&s"(keep) : "v"(gsrc), "s"(lds_dst) : "memory"); }
#define AT_WAIT_BAR(N) asm volatile("s_waitcnt vmcnt(" #N ") lgkmcnt(0)\n\ts_barrier" ::: "memory")
__device__ __forceinline__ void attn_unit(const Args& a, int b, int h, int qb, unsigned char* shm, int tid, bool pre, int nb, int nh) {
    const int lane = tid & 63, r32 = lane & 31, hi = lane >> 5; const int wid = __builtin_amdgcn_readfirstlane(tid >> 6);
    const size_t rowbase = (size_t)b * SEQ; const int q0 = qb * 256;
    const bf16* Qw = WSP(bf16, C_QF) + (rowbase + q0 + wid * 32) * QP + h * 96;
    const bf16* Kh = WSP(bf16, C_KF) + rowbase * QP + h * 96; const bf16* Vh = WSP(bf16, C_VV) + rowbase * 1024 + h * 64;
    const unsigned lds0 = (unsigned)(uintptr_t)shm;
    float* wsf = (float*)(shm + AT_WS) + wid * 64;
    const int krow = 4 * wid + (lane >> 4), kc = (lane & 15) ^ (krow & 15);
    const bf16* ksrc0 = Kh + (size_t)krow * QP + (kc < 12 ? kc : 0) * 8;
    const bf16* vsrc = Vh + (size_t)(16 * (wid & 3) + (lane >> 2)) * 1024 + (wid >> 2) * 32 + (lane & 3) * 8;
#define AT_DMA(t, slot) do { const unsigned sb_ = lds0 + (slot) * AT_SLOT; \
        glds16(ksrc0 + (size_t)(t) * 64 * QP, (unsigned)__builtin_amdgcn_readfirstlane(sb_ + wid * 1024)); \
        glds16(ksrc0 + (size_t)((t) * 64 + 32) * QP, (unsigned)__builtin_amdgcn_readfirstlane(sb_ + (wid + 8) * 1024)); \
        glds16(vsrc + (size_t)(t) * 64 * 1024, (unsigned)__builtin_amdgcn_readfirstlane(sb_ + AT_KB + wid * 1024)); } while (0)
    const int NT = 4 * qb + 4;
    bf16x8 qr[6];
#pragma unroll
    for (int d0 = 0; d0 < 6; ++d0) qr[d0] = *(const GAS bf16x8*)(Qw + (size_t)r32 * QP + d0 * 16 + hi * 8);
    asm volatile("" ::: "memory");
    if (!pre) { AT_DMA(0, 0); AT_DMA(1, 1); AT_DMA(2, 2); }
    float mrow = -INFINITY, lrow = 0.f; f32x16 o[2];
#pragma unroll
    for (int r = 0; r < 16; ++r) { o[0][r] = 0.f; o[1][r] = 0.f; }
    const int qrel = wid * 32 + r32;
    for (int t = 0; t < NT; ++t) {
        if (t + 2 < NT) AT_WAIT_BAR(6); else if (t + 1 < NT) AT_WAIT_BAR(3); else AT_WAIT_BAR(0);
        if (t + 3 < NT) AT_DMA(t + 3, (t + 3) & 3);
        else if (t == NT - 1 && nb >= 0) {
            const bf16* Kn = WSP(bf16, C_KF) + (size_t)nb * SEQ * QP + nh * 96; const bf16* Vn = WSP(bf16, C_VV) + (size_t)nb * SEQ * 1024 + nh * 64;
            const bf16* kn0 = Kn + (size_t)krow * QP + (kc < 12 ? kc : 0) * 8; const bf16* vn0 = Vn + (size_t)(16 * (wid & 3) + (lane >> 2)) * 1024 + (wid >> 2) * 32 + (lane & 3) * 8;
#pragma unroll
            for (int q = 0; q < 3; ++q) { const unsigned sb_ = lds0 + q * AT_SLOT;
                glds16(kn0 + (size_t)q * 64 * QP, (unsigned)__builtin_amdgcn_readfirstlane(sb_ + wid * 1024));
                glds16(kn0 + (size_t)(q * 64 + 32) * QP, (unsigned)__builtin_amdgcn_readfirstlane(sb_ + (wid + 8) * 1024));
                glds16(vn0 + (size_t)q * 64 * 1024, (unsigned)__builtin_amdgcn_readfirstlane(sb_ + AT_KB + wid * 1024)); } }
        const int jb = t - (NT - 4);
        if (jb >= 0 && 64 * jb > 32 * wid + 31) continue;
        typedef short v4i16_t __attribute__((ext_vector_type(4)));
        const LAS unsigned char* vp = (const LAS unsigned char*)shm + (t & 3) * AT_SLOT + AT_KB + ((lane >> 4) & 1) * 32 + (lane & 3) * 8 + (4 * hi + ((lane & 15) >> 2)) * 64;
        bf16x4 vlo[2][4], vhh[2][4];
#pragma unroll
        for (int d0 = 0; d0 < 2; ++d0)
#pragma unroll
            for (int ks = 0; ks < 4; ++ks) {
                vlo[d0][ks] = __builtin_bit_cast(bf16x4, __builtin_amdgcn_ds_read_tr16_b64_v4i16((LAS v4i16_t*)(vp + d0 * 4096 + ks * 1024)));
                vhh[d0][ks] = __builtin_bit_cast(bf16x4, __builtin_amdgcn_ds_read_tr16_b64_v4i16((LAS v4i16_t*)(vp + d0 * 4096 + ks * 1024 + 512))); }
        const unsigned char* Ks = shm + (t & 3) * AT_SLOT; const unsigned char* kb = Ks + r32 * 256; const int ksw = r32 & 15;
        f32x16 p0, p1;
#pragma unroll
        for (int r = 0; r < 16; ++r) { p0[r] = 0.f; p1[r] = 0.f; }
#pragma unroll
        for (int d0 = 0; d0 < 6; ++d0) { const int ko = ((2 * d0 + hi) ^ ksw) * 16; const bf16x8 b0 = *(const bf16x8*)(kb + ko), b1 = *(const bf16x8*)(kb + 8192 + ko); p0 = MFMA32(b0, qr[d0], p0); p1 = MFMA32(b1, qr[d0], p1); }
        if (jb >= 0) { const int kb0 = 64 * jb + 4 * hi;
#pragma unroll
            for (int r = 0; r < 16; ++r) { const int kv = kb0 + (r & 3) + 8 * (r >> 2); if (kv > qrel) p0[r] = -INFINITY; if (kv + 32 > qrel) p1[r] = -INFINITY; } }
        float rm = fmaxf(p0[0], p1[0]);
#pragma unroll
        for (int r = 1; r < 16; ++r) rm = fmaxf(rm, fmaxf(p0[r], p1[r]));
        { auto rr = __builtin_amdgcn_permlane32_swap(__float_as_uint(rm), __float_as_uint(rm), false, false); rm = fmaxf(__uint_as_float(rr[0]), __uint_as_float(rr[1])); }
        const float mn = fmaxf(mrow, rm); const float alpha = __builtin_amdgcn_exp2f(mrow - mn); mrow = mn;
        float rs = 0.f;
#pragma unroll
        for (int r = 0; r < 16; ++r) { p0[r] = __builtin_amdgcn_exp2f(p0[r] - mn); p1[r] = __builtin_amdgcn_exp2f(p1[r] - mn); rs += p0[r] + p1[r]; }
        lrow = lrow * alpha + rs;
        if (hi == 0) wsf[r32] = alpha;
        LDS_WAIT();
#pragma unroll
        for (int r = 0; r < 16; ++r) { const float al = wsf[crow(r, hi)]; o[0][r] *= al; o[1][r] *= al; }
        const bf16x8 pa0 = mk8(pk2(p0[0], p0[1]), pk2(p0[2], p0[3]), pk2(p0[4], p0[5]), pk2(p0[6], p0[7])), pa1 = mk8(pk2(p0[8], p0[9]), pk2(p0[10], p0[11]), pk2(p0[12], p0[13]), pk2(p0[14], p0[15]));
        const bf16x8 pa2 = mk8(pk2(p1[0], p1[1]), pk2(p1[2], p1[3]), pk2(p1[4], p1[5]), pk2(p1[6], p1[7])), pa3 = mk8(pk2(p1[8], p1[9]), pk2(p1[10], p1[11]), pk2(p1[12], p1[13]), pk2(p1[14], p1[15]));
        {
#define AT_PK(d, k) (bf16x8){vlo[d][k][0], vlo[d][k][1], vlo[d][k][2], vlo[d][k][3], vhh[d][k][0], vhh[d][k][1], vhh[d][k][2], vhh[d][k][3]}
            o[0] = MFMA32(pa0, AT_PK(0, 0), o[0]); o[1] = MFMA32(pa0, AT_PK(1, 0), o[1]); o[0] = MFMA32(pa1, AT_PK(0, 1), o[0]); o[1] = MFMA32(pa1, AT_PK(1, 1), o[1]);
            o[0] = MFMA32(pa2, AT_PK(0, 2), o[0]); o[1] = MFMA32(pa2, AT_PK(1, 2), o[1]); o[0] = MFMA32(pa3, AT_PK(0, 3), o[0]); o[1] = MFMA32(pa3, AT_PK(1, 3), o[1]);
#undef AT_PK
        }
    }
    { auto rr = __builtin_amdgcn_permlane32_swap(__float_as_uint(lrow), __float_as_uint(lrow), false, false); lrow = __uint_as_float(rr[0]) + __uint_as_float(rr[1]); }
    if (hi == 0) wsf[32 + r32] = lrow;
    LDS_WAIT();
    bf16* Ow = WSP(bf16, C_OA) + (rowbase + q0 + wid * 32) * 1024 + h * 64;
    { bf16* stg = (bf16*)(shm + AT_OST) + wid * 2048;
#pragma unroll
      for (int r = 0; r < 16; ++r) { const int orow = crow(r, hi); const float rl = __builtin_amdgcn_rcpf(wsf[32 + orow]);
#pragma unroll
          for (int d0 = 0; d0 < 2; ++d0) stg[orow * 64 + d0 * 32 + r32] = (bf16)f2bf(o[d0][r] * rl); }
      LDS_WAIT();
#pragma unroll
      for (int i = 0; i < 4; ++i) { const int row = i * 8 + (lane >> 3), ch8 = lane & 7; const v4u v = *(const v4u*)(stg + row * 64 + ch8 * 8); *(GAS v4u*)(Ow + (size_t)row * 1024 + ch8 * 8) = v; } }
    asm volatile("s_waitcnt lgkmcnt(0)\n\ts_barrier" ::: "memory");
#undef AT_DMA
}

constexpr int DA_L = 0, DA_IR = 128 * 296 * 2, DA_ML = DA_IR + 128 * 16 * 4, DA_CTX = DA_ML + 8 * 16 * 2 * 4, DA_QC = DA_CTX + 16 * 256 * 4, DA_END = DA_QC + 16 * 296 * 2;
static_assert(DA_END <= RING_BYTES, "decode attention LDS");
__device__ __forceinline__ void dec_attn_item(const Args& a, const Ctx& c, unsigned char* lds, int item) {
    const int b = item >> 3, split = item & 7; const int l15 = c.lane & 15, kq = c.lane >> 4, w = c.wave;
    bf16* L = (bf16*)(lds + DA_L); float* IR = (float*)(lds + DA_IR); float* MLs = (float*)(lds + DA_ML); float* CTX = (float*)(lds + DA_CTX);
    const int* pt = (const int*)a.in[IN_PT] + b * NPAGES + split * 8;
    bf16* QC = (bf16*)(lds + DA_QC);
    for (int i = c.tid; i < 16 * 36; i += NTHR) { const int hh = i / 36, q8 = i - hh * 36; *(v4u*)(QC + hh * 296 + 8 * q8) = *(const GAS v4u*)(WSP(bf16, D_QCAT) + ((size_t)b * 16 + hh) * 288 + 8 * q8); }
    f32x4 ctx[16];
#pragma unroll
    for (int ct = 0; ct < 16; ++ct) ctx[ct] = (f32x4){0.f, 0.f, 0.f, 0.f};
    float mh = -INFINITY, lh = 0.f;
    f32x4 v[19];
    { const f32x4* src = (const f32x4*)(a.in[IN_CACHE] + (size_t)pt[0] * (128 * ROWW));
#pragma unroll
      for (int k = 0; k < 19; ++k) v[k] = __builtin_nontemporal_load(src + c.tid + 512 * k); }
    for (int pg = 0; pg < 8; ++pg) {
        int tid_ = c.tid; asm volatile("" : "+v"(tid_));
        __syncthreads();
#pragma unroll
        for (int k = 0; k < 19; ++k) { const int idx = tid_ + 512 * k, row = idx / 76, c4 = idx - row * 76;
            if (c4 < 72) { v2u o = {pk2(v[k].x, v[k].y), pk2(v[k].z, v[k].w)}; *(v2u*)(L + row * 296 + 4 * c4) = o; }
            else *(f32x4*)(IR + row * 16 + 4 * (c4 - 72)) = v[k]; }
        __syncthreads();
        if (pg + 1 < 8) { const f32x4* src = (const f32x4*)(a.in[IN_CACHE] + (size_t)pt[pg + 1] * (128 * ROWW));
#pragma unroll
            for (int k = 0; k < 19; ++k) v[k] = __builtin_nontemporal_load(src + tid_ + 512 * k); }
        f32x4 acc = {0.f, 0.f, 0.f, 0.f};
        { const bf16* lr = L + (16 * w + l15) * 296 + 8 * kq;
#pragma unroll
          for (int ks = 0; ks < 9; ++ks) { const bf16x8 av = *(const bf16x8*)(lr + 32 * ks), qv = *(const bf16x8*)(QC + l15 * 296 + 8 * kq + 32 * ks); acc = MFMA16(av, qv, acc); } }
        float sc[4]; float ml = -INFINITY;
#pragma unroll
        for (int r = 0; r < 4; ++r) { sc[r] = acc[r] * IR[(16 * w + 4 * kq + r) * 16 + l15]; ml = fmaxf(ml, sc[r]); }
        ml = fmaxf(ml, __shfl_xor(ml, 16)); ml = fmaxf(ml, __shfl_xor(ml, 32));
        const float mn = fmaxf(mh, ml);
        if (__any(mn > mh)) { const float alpha = __builtin_amdgcn_exp2f(mh - mn); lh *= alpha;
            float al[4];
#pragma unroll
            for (int r = 0; r < 4; ++r) al[r] = __shfl(alpha, 4 * kq + r);
#pragma unroll
            for (int ct = 0; ct < 16; ++ct) { ctx[ct].x *= al[0]; ctx[ct].y *= al[1]; ctx[ct].z *= al[2]; ctx[ct].w *= al[3]; }
            mh = mn; }
        float p[4];
#pragma unroll
        for (int r = 0; r < 4; ++r) { p[r] = __builtin_amdgcn_exp2f(sc[r] - mh); lh += p[r]; }
        v2u pw = {pk2(p[0], p[1]), pk2(p[2], p[3])}; const bf16x4 pa = __builtin_bit_cast(bf16x4, pw);
        typedef short v4i16_t __attribute__((ext_vector_type(4)));
        const LAS unsigned char* ltp = (const LAS unsigned char*)lds + DA_L + ((16 * w + 4 * kq + (l15 >> 2)) * 296 + 4 * (l15 & 3)) * 2;
#pragma unroll
        for (int ct = 0; ct < 16; ++ct) { const bf16x4 bfr = __builtin_bit_cast(bf16x4, __builtin_amdgcn_ds_read_tr16_b64_v4i16((LAS v4i16_t*)(ltp + 32 * ct))); ctx[ct] = MFMA16K16(pa, bfr, ctx[ct]); }
    }
    lh += __shfl_xor(lh, 16); lh += __shfl_xor(lh, 32);
    __syncthreads();
    if (kq == 0) { MLs[(w * 16 + l15) * 2] = mh; MLs[(w * 16 + l15) * 2 + 1] = lh; }
    for (int i = c.tid; i < 4096; i += NTHR) CTX[i] = 0.f;
    __syncthreads();
    float fac[4]; float Mx[4];
#pragma unroll
    for (int r = 0; r < 4; ++r) { const int hh = 4 * kq + r; float M = -INFINITY;
#pragma unroll
        for (int ww = 0; ww < 8; ++ww) M = fmaxf(M, MLs[(ww * 16 + hh) * 2]);
        Mx[r] = M; fac[r] = __builtin_amdgcn_exp2f(__shfl(mh, hh) - M); }
    for (int ww = 0; ww < 8; ++ww) { if (w == ww) {
#pragma unroll
            for (int ct = 0; ct < 16; ++ct) { float* cp = CTX + (4 * kq) * 256 + 16 * ct + l15; cp[0] += ctx[ct].x * fac[0]; cp[256] += ctx[ct].y * fac[1]; cp[512] += ctx[ct].z * fac[2]; cp[768] += ctx[ct].w * fac[3]; } }
        __syncthreads(); }
    float* part = WSP(float, D_PART) + (size_t)item * 4096;
    for (int i = c.tid; i < 1024; i += NTHR) *(GAS f32x4*)(part + 4 * i) = *(const f32x4*)(CTX + 4 * i);
    if (c.tid < 16) { float M = -INFINITY;
#pragma unroll
        for (int ww = 0; ww < 8; ++ww) M = fmaxf(M, MLs[(ww * 16 + c.tid) * 2]);
        float Lsum = 0.f;
#pragma unroll
        for (int ww = 0; ww < 8; ++ww) Lsum += MLs[(ww * 16 + c.tid) * 2 + 1] * __builtin_amdgcn_exp2f(MLs[(ww * 16 + c.tid) * 2] - M);
        float* ml = WSP(float, D_ML) + (size_t)item * 32; ml[2 * c.tid] = M; ml[2 * c.tid + 1] = Lsum; }
    __syncthreads();
}
__device__ __forceinline__ void combine_item(const Args& a, int item, int lane, float* scr) {
    const int b = item >> 4, h = item & 15; const float* rows = a.out + O_SROWS + (size_t)b * ROWW;
    const bf16* qc = WSP(bf16, D_QCAT) + ((size_t)b * 16 + h) * 288;
    float cn[4]; float dot = 0.f;
#pragma unroll
    for (int j = 0; j < 4; ++j) { cn[j] = rows[lane + 64 * j]; dot += bf2f(qc[lane + 64 * j]) * cn[j]; }
    if (lane < 32) dot += bf2f(qc[256 + lane]) * rows[256 + lane];
    const float snew = wave_sum(dot) * rows[288 + h];
    float M = snew; float mj[8], lj[8];
#pragma unroll
    for (int j = 0; j < 8; ++j) { const float* ml = WSP(float, D_ML) + (size_t)(b * 8 + j) * 32 + 2 * h; mj[j] = ml[0]; lj[j] = ml[1]; M = fmaxf(M, mj[j]); }
    const float fn = __builtin_amdgcn_exp2f(snew - M); float Lsum = fn; float acc[4];
#pragma unroll
    for (int k = 0; k < 4; ++k) acc[k] = fn * cn[k];
#pragma unroll
    for (int j = 0; j < 8; ++j) { const float f = __builtin_amdgcn_exp2f(mj[j] - M); Lsum += lj[j] * f; const float* p = WSP(float, D_PART) + (size_t)(b * 8 + j) * 4096 + h * 256;
#pragma unroll
        for (int k = 0; k < 4; ++k) acc[k] += f * p[lane + 64 * k]; }
    const float inv = 1.0f / Lsum;
#pragma unroll
    for (int k = 0; k < 4; ++k) scr[lane + 64 * k] = acc[k] * inv;
    LDS_WAIT();
    const float* wv = a.in[IN_W_UV] + h * 64 + lane; float o = 0.f;
#pragma unroll 8
    for (int cc = 0; cc < 256; ++cc) o += scr[cc] * wv[(size_t)cc * 1024];
    WSP(bf16, C_OA)[(size_t)(MP + b) * 1024 + h * 64 + lane] = (bf16)f2bf(o);
    LDS_WAIT();
}
constexpr int NPH = 20;
#ifndef I14_QUEUE
#define I14_QUEUE 0
#endif
#ifndef ATTN_REP
#define ATTN_REP 1
#endif
#ifndef DEC_REP
#define DEC_REP 1
#endif
template <class Epi> __device__ __forceinline__ void run_gemm(unsigned char* lds, const bf16* A, const bf16* Bt, int N, int K, const Epi& E) {
    pg8::Gemm g{A, Bt, MP, N, K}; pg8::StaticOrder S; S.init(MP, N, (int)gridDim.x, (int)blockIdx.x);
    pg8::gemm_phase<Epi, pg8::StaticOrder, true, true>((PG8_LAS unsigned char*)lds, g, S, E);
}
__global__ void __launch_bounds__(NTHR, 2) hybrid_fwd(Args a) {
    extern __shared__ __attribute__((aligned(16))) unsigned char lds[];
    Ctx c; c.tid = threadIdx.x; c.lane = c.tid & 63; c.wave = __builtin_amdgcn_readfirstlane(c.tid >> 6); c.bid = blockIdx.x; c.G = gridDim.x; c.gw = c.bid * NWAVES + c.wave; c.NGW = c.G * NWAVES;
    for (int u = c.tid; u < (LDS_BYTES - LDSCTL_OFF) / 4; u += NTHR) ((LAS unsigned*)((LAS unsigned char*)lds + LDSCTL_OFF))[u] = 0u;
    __syncthreads();
#if MK_ONE_LAUNCH
    XcdBarrier bar = xcd_barrier_post((unsigned*)(a.ws + WS_CTL) + CW_BAR, (volatile LAS unsigned*)((LAS unsigned char*)lds + MISC_OFF) + 8);
#define GRID_BAR() xcd_barrier(bar)
#else
#define GRID_BAR() do {} while (0)
#endif
    const int lo = a.ph_lo, hi = a.ph_hi;
#ifndef PHMASK
#define PHMASK 0xFFFFFu
#endif
#define IN(k) ((((PHMASK) >> (k)) & 1u) && lo <= (k) && (k) < hi)
#define NEXTPH(k) (((k) == 5 || (k) == 8 || (k) == 10 || (k) == 16) ? (k) + 2 : (k) + 1)
#define SEAM(k) do { if (IN(k) && IN(NEXTPH(k))) GRID_BAR(); } while (0)
    float* wscr = (float*)(lds + c.wave * 8192);

    if (IN(0)) { ph_prologue(a, c, lds); } SEAM(0);
    if (IN(1)) { { SEpiBf16 e{WSP(bf16, A_PROJ) + (size_t)MP * PROJW, PROJW}; small_gemm(c, WSP(bf16, A_XN) + (size_t)MP * DM, DM, WSP(bf16, W_INA), 1024, PROJW / 16, e); }
        pg8::EpiBf16<0> E{WSP(bf16, A_PROJ), PROJW, nullptr, 0, 0, 1.f}; run_gemm(lds, WSP(bf16, A_XN), WSP(bf16, W_INA), PROJW, 1024, E);
        { const int nun = 64 * (PROJW / 256), rem = nun % c.G; const int first = rem ? rem : 0, nw = c.G - first;
          if (c.bid >= first) { __syncthreads(); ph_late_weights<0>(a, c, lds, (c.bid - first) * NWAVES + c.wave, nw * NWAVES); } } } SEAM(1);
    if (IN(2)) { for (int it = c.bid; it < 1024; it += c.G) g1_item(a, c, lds, it);
        for (int it = c.bid; it < 512; it += c.G) s1_item(a, c, lds, it); } SEAM(2);
    if (IN(3)) { const int nchainblk = (c.G > 16) ? 16 : 0;
        if (!(a.flags & 1)) for (int bh = c.bid; bh < 16; bh += c.G) { g2_block(a, c, lds, bh); __syncthreads(); }
        if (c.bid >= nchainblk && !(a.flags & 2)) { const int wb = c.bid - nchainblk, nwb = c.G - nchainblk;
            if (!(a.flags & 4)) for (int t = wb * NTHR + c.tid; t < 32 * 2048; t += nwb * NTHR) s2_task(a, t);
            for (int t = wb * NTHR + c.tid; t < 4 * 3 * 2560; t += nwb * NTHR) prompt_conv_out(a, t);
            unsigned* sbw = (unsigned*)(a.ws + WS_CTL) + CW_QATTN;
            sub_arrive(sbw);
            if (!(a.flags & 8)) for (int it = wb; it < 512; it += nwb) gdn_dec_item(a, c, lds, it);
            if (!(a.flags & 16)) for (int it = wb; it < 256; it += nwb) ssd_dec_item(a, c, lds, it);
            sub_wait(sbw, (unsigned)nwb, (unsigned*)(a.ws + WS_CTL) + CW_BAR);
            for (int it = wb; it < 512; it += nwb) s3_item(a, c, lds, it); } } SEAM(3);
    if (IN(4)) { for (int it = c.bid; it < 1024; it += c.G) g3_item(a, c, lds, it); } SEAM(4);
    if (IN(5)) { float* ssq = (float*)(a.ws + WS_CTL) + CW_SSQ;
        { SEpiRes e{a.in[IN_XS], nullptr, DM, WSP(bf16, A_XN) + (size_t)MP * DM, ssq + MP, nullptr}; small_gemm(c, WSP(bf16, A_MIX) + (size_t)MP * DM, DM, WSP(bf16, W_OUTA), 1024, 64, e); }
        pg8::EpiResF32 E{a.in[IN_XP], nullptr, DM, WSP(bf16, A_XN), ssq, nullptr}; run_gemm(lds, WSP(bf16, A_MIX), WSP(bf16, W_OUTA), 1024, 1024, E); } SEAM(5);
    if (IN(7)) { const float* ssq = (const float*)(a.ws + WS_CTL) + CW_SSQ;
        { SEpiBf16 e{WSP(bf16, A_H) + (size_t)MP * DFF, DFF}; small_gemm_glu(c, WSP(bf16, A_XN) + (size_t)MP * DM, DM, WSP(bf16, W_GU0), 1024, ssq + MP, e); }
        pg8::EpiSwiGLU E{WSP(bf16, A_H), DFF, ssq}; run_gemm(lds, WSP(bf16, A_XN), WSP(bf16, W_GU0), 2 * DFF, 1024, E);
        { const int nun = 64 * (2 * DFF / 256), rem = nun % c.G; const int first = rem ? rem : 0, nw = c.G - first;
          if (c.bid >= first) { __syncthreads(); ph_late_weights<1>(a, c, lds, (c.bid - first) * NWAVES + c.wave, nw * NWAVES); } } } SEAM(7);
    if (IN(8)) { float* ssq = (float*)(a.ws + WS_CTL) + CW_SSQ + MT;
        { SEpiRes e{nullptr, WSP(bf16, A_XN) + (size_t)MP * DM, DM, WSP(bf16, A_XN) + (size_t)MP * DM, ssq + MP, nullptr}; small_gemm(c, WSP(bf16, A_H) + (size_t)MP * DFF, DFF, WSP(bf16, W_DN0), DFF, 64, e); }
        pg8::EpiResF32 E{nullptr, WSP(bf16, A_XN), DM, WSP(bf16, A_XN), ssq, nullptr}; run_gemm(lds, WSP(bf16, A_H), WSP(bf16, W_DN0), 1024, DFF, E); } SEAM(8);
    if (IN(10)) { float* sb = (float*)(a.ws + WS_CTL) + CW_SSQ; const float* ssx = sb + MT; float* ssq_q = sb + 3 * MT; float* ssq_c = sb + 4 * MT;
        { SEpiInC e{WSP(float, C_CKV) + (size_t)MP * DM, ssx + MP, WSP(bf16, C_CQN) + (size_t)MP * 512, WSP(bf16, C_CN) + (size_t)MP * 256, ssq_q + MP, ssq_c + MP}; small_gemm(c, WSP(bf16, A_XN) + (size_t)MP * DM, DM, WSP(bf16, W_INC), 1024, 64, e); }
        pg8::EpiInC E{WSP(float, C_CKV), DM, ssx, WSP(bf16, C_CQN), WSP(bf16, C_CN), ssq_q, ssq_c}; run_gemm(lds, WSP(bf16, A_XN), WSP(bf16, W_INC), 1024, 1024, E); } SEAM(10);
    if (IN(12)) { const float* sb = (const float*)(a.ws + WS_CTL) + CW_SSQ; const float* ssq_q = sb + 3 * MT; const float* ssq_c = sb + 4 * MT;
        { pg8::EpiBf16Rs E{WSP(bf16, C_QRAW), QP, ssq_q, 1.f / 512.f, 0, 0}; run_gemm(lds, WSP(bf16, C_CQN), WSP(bf16, W_UQ), QP, 512, E); }
        { const int rem = (64 * (QP / 256)) % c.G; Ctx c2 = c; if (rem) { c2.gw = (c.bid - rem) * NWAVES + c.wave; c2.NGW = (c.G - rem) * NWAVES; }
          if (c.bid >= rem) {
            { SEpiBf16Rs e{WSP(bf16, C_QRAW) + (size_t)MP * QP, QP, ssq_q + MP, 1.f / 512.f}; small_gemm(c2, WSP(bf16, C_CQN) + (size_t)MP * 512, 512, WSP(bf16, W_UQ), 512, QP / 16, e); }
            { SEpiBf16Rs e{WSP(bf16, C_KN) + (size_t)MP * 1024, 1024, ssq_c + MP, 1.f / 256.f}; small_gemm(c2, WSP(bf16, C_CN) + (size_t)MP * 256, 256, WSP(bf16, W_UKV), 256, 64, e); } } }
        { pg8::EpiBf16Rs E{WSP(bf16, C_KN), 1024, ssq_c, 1.f / 256.f, 1024, (size_t)(C_VV - C_KN) / 2}; run_gemm(lds, WSP(bf16, C_CN), WSP(bf16, W_UKV), 2048, 256, E); } } SEAM(12);
    if (IN(13)) { int m = c.gw; if (m < MT) { C5In cur = c5_load(a, m, c.lane);
            for (; m < MT; m += c.NGW) { const int mn = m + c.NGW; C5In nxt = cur; if (mn < MT) nxt = c5_load(a, mn, c.lane); c5_row(a, m, c.lane, wscr, cur); cur = nxt; } }
        for (int it = c.gw; it < MS * 16; it += c.NGW) qcat_item(a, it, c.lane, wscr); } SEAM(13);
#if I14_QUEUE
    if (IN(14)) {
        gu32* qa = (gu32*)(a.ws + WS_CTL) + CW_QATTN; gu32* qd = (gu32*)(a.ws + WS_CTL) + CW_QDEC;
        volatile int* qslot = (volatile int*)(lds + LDSCTL_OFF + 64);
        const bool dec_first = ((c.bid >> 3) % 5) < 2;
        bool attn_dry = false, dec_dry = false;
        for (;;) {
            if (c.tid == 0) { int kind = -1, idx = 0;
                for (int pass = 0; pass < 2 && kind < 0; ++pass) { const bool want_dec = (pass == 0) == dec_first;
                    if (want_dec) { if (!dec_dry) { idx = (int)__hip_atomic_fetch_add(qd, 1u, RLX_AGENT); if (idx < MS * 8) kind = 1; else dec_dry = true; } }
                    else { if (!attn_dry) { idx = (int)__hip_atomic_fetch_add(qa, 1u, RLX_AGENT); if (idx < 1024) kind = 0; else attn_dry = true; } } }
                qslot[0] = kind; qslot[1] = idx; }
            __syncthreads();
            const int kind = qslot[0], idx = qslot[1];
            __syncthreads();
            if (kind < 0) break;
            if (kind == 0) { const int qb = 15 - (idx >> 6), bh = idx & 63; attn_unit(a, bh >> 4, bh & 15, qb, lds, c.tid); }
            else dec_attn_item(a, c, lds, idx);
            __syncthreads();
        } } SEAM(14);
#else
    if (IN(14)) {
        for (int pass = 0; pass < 2; ++pass) { const bool do_attn = ((c.bid & 1) == 0) == (pass == 0);
            if (do_attn) { bool pre = false;
                for (int i = 0;; ++i) { const int idx = i * c.G + c.bid; if (idx >= 1024 || (a.flags & 32)) break; const int r = idx >> 8, vv = idx & 255, v = (vv & 7) * 32 + (vv >> 3)  , bh = v >> 2, s_ = v & 3;
                    const int qb = (r == 0) ? s_ : (r == 1) ? 7 - s_ : (r == 2) ? 8 + s_ : 15 - s_;
                    const int idn = idx + c.G; int nb = -1, nh = 0; if (idn < 1024) { const int vn = idn & 255, v2 = (vn & 7) * 32 + (vn >> 3), bh2 = v2 >> 2; nb = bh2 >> 4; nh = bh2 & 15; }
                    attn_unit(a, bh >> 4, bh & 15, qb, lds, c.tid, pre, nb, nh); pre = (nb >= 0); } }
            else { if (!(a.flags & 16) && !((a.flags & 64) && !(c.bid & 1))) for (int it = c.bid; it < MS * 8; it += c.G) dec_attn_item(a, c, lds, it); }
            __syncthreads(); } } SEAM(14);
#endif
    if (IN(15)) { for (int it = c.gw; it < MS * 16; it += c.NGW) combine_item(a, it, c.lane, wscr); } SEAM(15);
    if (IN(16)) { float* ssq = (float*)(a.ws + WS_CTL) + CW_SSQ + 2 * MT;
        { SEpiRes e{nullptr, WSP(bf16, A_XN) + (size_t)MP * DM, DM, WSP(bf16, A_XN) + (size_t)MP * DM, ssq + MP, nullptr}; small_gemm(c, WSP(bf16, C_OA) + (size_t)MP * 1024, 1024, WSP(bf16, W_OUTC), 1024, 64, e); }
        pg8::EpiResF32 E{nullptr, WSP(bf16, A_XN), DM, WSP(bf16, A_XN), ssq, nullptr}; run_gemm(lds, WSP(bf16, C_OA), WSP(bf16, W_OUTC), 1024, 1024, E); } SEAM(16);
    if (IN(18)) { const float* ssq = (const float*)(a.ws + WS_CTL) + CW_SSQ + 2 * MT;
        pg8::EpiSwiGLU E{WSP(bf16, A_H), DFF, ssq}; run_gemm(lds, WSP(bf16, A_XN), WSP(bf16, W_GU1), 2 * DFF, 1024, E);
        { const int rem = (64 * (2 * DFF / 256)) % c.G; Ctx c2 = c; if (rem) { c2.gw = (c.bid - rem) * NWAVES + c.wave; c2.NGW = (c.G - rem) * NWAVES; }
          if (c.bid >= rem) { SEpiBf16 e{WSP(bf16, A_H) + (size_t)MP * DFF, DFF}; small_gemm_glu(c2, WSP(bf16, A_XN) + (size_t)MP * DM, DM, WSP(bf16, W_GU1), 1024, ssq + MP, e); } } } SEAM(18);
    if (IN(19)) { { SEpiRes e{nullptr, WSP(bf16, A_XN) + (size_t)MP * DM, DM, nullptr, nullptr, a.out + O_YS}; small_gemm(c, WSP(bf16, A_H) + (size_t)MP * DFF, DFF, WSP(bf16, W_DN1), DFF, 64, e); }
        pg8::EpiResF32 E{nullptr, WSP(bf16, A_XN), DM, nullptr, nullptr, a.out + O_YP}; run_gemm(lds, WSP(bf16, A_H), WSP(bf16, W_DN1), 1024, DFF, E); }
#undef IN
#undef SEAM
}

extern "C" void kernel_launch(void* const* d_in, const int* in_sizes, int n_in, void* d_out, int out_size, void* d_ws, size_t ws_size, hipStream_t stream) {
    static int grid = 0;
    if (grid == 0) {
        if (n_in != 34 || out_size != (int)O_END || ws_size < WS_END) { fprintf(stderr, "kernel_launch: unexpected problem shape (n_in %d, out %d, ws %zu); nothing launched\n", n_in, out_size, ws_size); grid = -1; return; }
        int dev = 0, cus = 0, per_cu = 0;
        if (hipGetDevice(&dev) != hipSuccess || hipDeviceGetAttribute(&cus, hipDeviceAttributeMultiprocessorCount, dev) != hipSuccess) { grid = -1; return; }
        if (hipFuncSetAttribute((const void*)hybrid_fwd, hipFuncAttributeMaxDynamicSharedMemorySize, LDS_BYTES) != hipSuccess) { fprintf(stderr, "kernel_launch: hipFuncSetAttribute failed\n"); grid = -1; return; }
        if (hipOccupancyMaxActiveBlocksPerMultiprocessor(&per_cu, (const void*)hybrid_fwd, NTHR, LDS_BYTES) != hipSuccess || per_cu < 1) { fprintf(stderr, "kernel_launch: occupancy query says %d blocks per CU\n", per_cu); }
        (void)hipGetLastError();
        grid = cus;
    }
    if (grid < 0) return;
    if (hipMemsetAsync((char*)d_ws + WS_CTL, 0, CTL_ZERO_BYTES, stream) != hipSuccess) return;
    Args a{};
    for (int i = 0; i < 34; ++i) a.in[i] = (const float*)d_in[i];
    a.out = (float*)d_out; a.ws = (unsigned char*)d_ws;
#if MK_ONE_LAUNCH && !defined(PROBE_PHASE)
    a.ph_lo = 0; a.ph_hi = NPH;
    hipLaunchKernelGGL(hybrid_fwd, dim3(grid), dim3(NTHR), LDS_BYTES, stream, a);
#elif defined(PROBE_PHASE)
    for (int k = 0; k < NPH; ++k) { a.ph_lo = k; a.ph_hi = k + 1; a.flags = 0; hipLaunchKernelGGL(hybrid_fwd, dim3(grid), dim3(NTHR), LDS_BYTES, stream, a);
        if (k == PROBE_PHASE) { a.flags = PROBE_FLAGS; hipLaunchKernelGGL(hybrid_fwd, dim3(grid), dim3(NTHR), LDS_BYTES, stream, a); } }
#else
    for (int k = 0; k < NPH; ++k) { a.ph_lo = k; a.ph_hi = k + 1; hipLaunchKernelGGL(hybrid_fwd, dim3(grid), dim3(NTHR), LDS_BYTES, stream, a); }
#endif
}
```
